# Optimizing an MI355X kernel written in HIP

```python
import math
import jax, jax.numpy as jnp
from jax import lax
import numpy as np

D_MODEL = 1024
BATCH = 2
SEQ = 16384
DEPTH = 2

CHUNK = 64
N_META = 16
Q_BLOCK = 128
N_A = DEPTH // 2
N_B = DEPTH - N_A
ALPHA = (2.0 * DEPTH) ** 0.25
BETA = (8.0 * DEPTH) ** -0.25
CONV_W = 31
N_HEADS = 8
HEAD_DIM = D_MODEL // N_HEADS // 2
V_DIM = 2 * HEAD_DIM
ROT_DIM = HEAD_DIM // 4
ROPE_THETA = 500000.0
N_GROUPS = 4
EXPERTS_PER_GROUP = 4
N_EXPERTS = N_GROUPS * EXPERTS_PER_GROUP
TOP_K = 2
D_EXPERT = D_MODEL // 2
EPS = 1e-5

kernel_name = "yoco_conformer_diffattn_hmoe_trunk"


def layernorm(x, g, b):
    xf = x.astype(jnp.float32)
    mu = jnp.mean(xf, axis=-1, keepdims=True)
    var = jnp.mean(jnp.square(xf - mu), axis=-1, keepdims=True)
    y = (xf - mu) * lax.rsqrt(var + EPS)
    return (y * g.astype(jnp.float32) + b.astype(jnp.float32)).astype(x.dtype)


def rmsnorm(x, g):
    xf = x.astype(jnp.float32)
    y = xf * lax.rsqrt(jnp.mean(jnp.square(xf), axis=-1, keepdims=True) + EPS)
    return (y * g.astype(jnp.float32)).astype(x.dtype)


def chunk_ids(n):
    p = jnp.arange(n, dtype=jnp.int32)
    return jnp.where(p < N_META, 0, 1 + (p - N_META) // CHUNK)


def rotary_tables(n):
    pos = jnp.arange(n, dtype=jnp.float32)
    inv = ROPE_THETA ** (-jnp.arange(0, ROT_DIM, 2, dtype=jnp.float32) / ROT_DIM)
    ang = pos[:, None] * inv[None, :]
    return jnp.cos(ang), jnp.sin(ang)


def apply_partial_rope(t, cos, sin):
    half = ROT_DIM // 2
    c = cos[:, None, None, :]
    s = sin[:, None, None, :]
    tf = t[..., :ROT_DIM].astype(jnp.float32)
    t1, t2 = tf[..., :half], tf[..., half:]
    rot = jnp.concatenate([t1 * c - t2 * s, t1 * s + t2 * c], axis=-1).astype(t.dtype)
    return jnp.concatenate([rot, t[..., ROT_DIM:]], axis=-1)


def conformer_conv(x, w_pw1, b_pw1, w_dw, b_dw, ln_g, ln_b, w_pw2, b_pw2):
    h = x @ w_pw1 + b_pw1
    a, g = jnp.split(h, 2, axis=-1)
    h = a * jax.nn.sigmoid(g)
    hp = jnp.pad(h, ((0, 0), (CONV_W - 1, 0), (0, 0)))
    h = lax.conv_general_dilated(hp, w_dw[:, None, :], window_strides=(1,), padding='VALID',
                                 dimension_numbers=('NWC', 'WIO', 'NWC'),
                                 feature_group_count=D_MODEL) + b_dw
    h = jax.nn.silu(layernorm(h, ln_g, ln_b))
    return h @ w_pw2 + b_pw2


def hier_moe(x2d, w_group, b_group, w_expert, b_expert, w1, w3, w2):
    T = x2d.shape[0]
    g_prob = jax.nn.softmax((x2d @ w_group + b_group).astype(jnp.float32), axis=-1)
    g_w, g_idx = lax.top_k(g_prob, 1)
    e_logits = (x2d @ w_expert + b_expert).astype(jnp.float32).reshape(T, N_GROUPS, EXPERTS_PER_GROUP)
    e_logits = jnp.take_along_axis(e_logits, g_idx[:, :, None], axis=1)[:, 0]
    e_prob = jax.nn.softmax(e_logits, axis=-1)
    e_w, e_idx = lax.top_k(e_prob, TOP_K)
    e_w = e_w / jnp.sum(e_w, axis=-1, keepdims=True)
    w = (g_w * e_w).astype(x2d.dtype)
    flat_idx = g_idx * EXPERTS_PER_GROUP + e_idx
    combine = jnp.sum(jax.nn.one_hot(flat_idx, N_EXPERTS, dtype=x2d.dtype) * w[..., None], axis=1)

    def expert_step(acc, p):
        w1e, w3e, w2e, c = p
        h = jax.nn.silu(x2d @ w1e) * (x2d @ w3e)
        return acc + c[:, None] * (h @ w2e), None

    out, _ = lax.scan(expert_step, jnp.zeros_like(x2d), (w1, w3, w2, combine.T))
    return out


def diff_attention(x, k, v, w_q, lam_q1, lam_k1, lam_q2, lam_k2, subln_g, w_o, lam_init, cos, sin):
    B, L, _ = x.shape
    q = apply_partial_rope((x @ w_q).reshape(B, L, N_HEADS, 2, HEAD_DIM), cos, sin)
    lam = (jnp.exp(jnp.sum((lam_q1 * lam_k1).astype(jnp.float32)))
           - jnp.exp(jnp.sum((lam_q2 * lam_k2).astype(jnp.float32))) + lam_init)
    n_blocks = -(-L // Q_BLOCK)
    l_pad = n_blocks * Q_BLOCK
    q = jnp.pad(q, ((0, 0), (0, l_pad - L), (0, 0), (0, 0), (0, 0)))
    qb = q.reshape(B, n_blocks, Q_BLOCK, N_HEADS, 2, HEAD_DIM).transpose(1, 0, 2, 3, 4, 5)
    cid_q = chunk_ids(l_pad).reshape(n_blocks, Q_BLOCK)
    cid_k = chunk_ids(L)
    scale = HEAD_DIM ** -0.5

    def block(args):
        qi, ci = args
        s = jnp.einsum('bqhcd,bkhcd->bhcqk', qi, k).astype(jnp.float32) * scale
        mask = cid_k[None, :] <= ci[:, None]
        s = jnp.where(mask[None, None, None], s, jnp.finfo(jnp.float32).min)
        p = jax.nn.softmax(s, axis=-1)
        pd = (p[:, :, 0] - lam * p[:, :, 1]).astype(v.dtype)
        return jnp.einsum('bhqk,bkhe->bqhe', pd, v)

    o = lax.map(block, (qb, cid_q))
    o = o.transpose(1, 0, 2, 3, 4).reshape(B, l_pad, N_HEADS, V_DIM)[:, :L]
    o = rmsnorm(o, subln_g) * (1.0 - lam_init)
    return o.reshape(B, L, N_HEADS * V_DIM) @ w_o


def setup_inputs(seed: int = 0) -> dict:
    key = jax.random.key(seed)
    ks = jax.random.split(key, 32)
    f32 = jnp.float32

    def nrm(k, shape, scale):
        return jax.random.normal(k, shape, f32) * scale

    d = D_MODEL
    qkw = N_HEADS * 2 * HEAD_DIM
    vw = N_HEADS * V_DIM
    return {
        "x": nrm(ks[0], (BATCH, SEQ, d), 1.0),
        "meta_tokens": nrm(ks[1], (N_META, d), 1.0),
        "conv_w_pw1": nrm(ks[2], (N_A, d, 2 * d), d ** -0.5),
        "conv_b_pw1": nrm(ks[3], (N_A, 2 * d), 0.01),
        "conv_w_dw": nrm(ks[4], (N_A, CONV_W, d), CONV_W ** -0.5),
        "conv_b_dw": nrm(ks[5], (N_A, d), 0.01),
        "conv_ln_g": 1.0 + nrm(ks[6], (N_A, d), 0.02),
        "conv_ln_b": nrm(ks[7], (N_A, d), 0.01),
        "conv_w_pw2": nrm(ks[8], (N_A, d, d), BETA * d ** -0.5),
        "conv_b_pw2": nrm(ks[9], (N_A, d), 0.01),
        "kv_w_k": nrm(ks[10], (d, qkw), d ** -0.5),
        "kv_w_v": nrm(ks[11], (d, vw), BETA * d ** -0.5),
        "attn_w_q": nrm(ks[12], (N_B, d, qkw), d ** -0.5),
        "attn_lam_q1": nrm(ks[13], (N_B, HEAD_DIM), 0.1),
        "attn_lam_k1": nrm(ks[14], (N_B, HEAD_DIM), 0.1),
        "attn_lam_q2": nrm(ks[15], (N_B, HEAD_DIM), 0.1),
        "attn_lam_k2": nrm(ks[16], (N_B, HEAD_DIM), 0.1),
        "attn_subln_g": 1.0 + nrm(ks[17], (N_B, V_DIM), 0.02),
        "attn_w_o": nrm(ks[18], (N_B, vw, d), BETA * vw ** -0.5),
        "post_ln_g": 1.0 + nrm(ks[19], (DEPTH, 2, d), 0.02),
        "post_ln_b": nrm(ks[20], (DEPTH, 2, d), 0.01),
        "moe_w_group": nrm(ks[21], (DEPTH, d, N_GROUPS), d ** -0.5),
        "moe_b_group": nrm(ks[22], (DEPTH, N_GROUPS), 0.01),
        "moe_w_expert": nrm(ks[23], (DEPTH, d, N_EXPERTS), d ** -0.5),
        "moe_b_expert": nrm(ks[24], (DEPTH, N_EXPERTS), 0.01),
        "moe_w1": nrm(ks[25], (DEPTH, N_EXPERTS, d, D_EXPERT), d ** -0.5),
        "moe_w3": nrm(ks[26], (DEPTH, N_EXPERTS, d, D_EXPERT), d ** -0.5),
        "moe_w2": nrm(ks[27], (DEPTH, N_EXPERTS, D_EXPERT, d), BETA * D_EXPERT ** -0.5),
    }


def reference(x, meta_tokens, conv_w_pw1, conv_b_pw1, conv_w_dw, conv_b_dw, conv_ln_g, conv_ln_b,
              conv_w_pw2, conv_b_pw2, kv_w_k, kv_w_v, attn_w_q, attn_lam_q1, attn_lam_k1,
              attn_lam_q2, attn_lam_k2, attn_subln_g, attn_w_o, post_ln_g, post_ln_b,
              moe_w_group, moe_b_group, moe_w_expert, moe_b_expert, moe_w1, moe_w3, moe_w2):
    B, S, D = x.shape
    meta = jnp.broadcast_to(meta_tokens.astype(x.dtype)[None], (B, N_META, D))
    h = jnp.concatenate([meta, x], axis=1)
    L = h.shape[1]
    cos, sin = rotary_tables(L)
    k_shared = None
    v_shared = None
    for l in range(DEPTH):
        if l < N_A:
            a = l
            m = conformer_conv(h, conv_w_pw1[a], conv_b_pw1[a], conv_w_dw[a], conv_b_dw[a],
                               conv_ln_g[a], conv_ln_b[a], conv_w_pw2[a], conv_b_pw2[a])
        else:
            bi = l - N_A
            lam_init = 0.8 - 0.6 * math.exp(-0.3 * l)
            m = diff_attention(h, k_shared, v_shared, attn_w_q[bi], attn_lam_q1[bi], attn_lam_k1[bi],
                               attn_lam_q2[bi], attn_lam_k2[bi], attn_subln_g[bi], attn_w_o[bi],
                               lam_init, cos, sin)
        h = layernorm(ALPHA * h + m, post_ln_g[l, 0], post_ln_b[l, 0])
        f = hier_moe(h.reshape(B * L, D), moe_w_group[l], moe_b_group[l], moe_w_expert[l],
                     moe_b_expert[l], moe_w1[l], moe_w3[l], moe_w2[l]).reshape(B, L, D)
        h = layernorm(ALPHA * h + f, post_ln_g[l, 1], post_ln_b[l, 1])
        if l == N_A - 1:
            k_shared = apply_partial_rope((h @ kv_w_k).reshape(B, L, N_HEADS, 2, HEAD_DIM), cos, sin)
            v_shared = (h @ kv_w_v).reshape(B, L, N_HEADS, V_DIM)
    return h[:, N_META:]
```

```cpp
#include <hip/hip_runtime.h>
#include <cstdio>
#include <cstdint>

#ifndef MK_N_LAUNCHES
#define MK_N_LAUNCHES 1
#endif

namespace pg8 {
#define PG8_LAS __attribute__((address_space(3)))
typedef unsigned short bf16_t;
typedef short bf16x8 __attribute__((ext_vector_type(8)));
typedef float f32x4 __attribute__((ext_vector_type(4)));
typedef unsigned u32x4 __attribute__((ext_vector_type(4)));
constexpr int BM = 256, BK = 64, HALF = 128, HTB = HALF * BK * 2  , STAGE_BYTES = 8 * HTB, NXCD = 8, WGM = 8;

__host__ __device__ __forceinline__ int lds_byte(int r, int c) { const int st = (r >> 4) * 2 + (c >> 5), rr = r & 15, cc = c & 31, ob = rr * 64 + cc * 2; return st * 1024 + (ob ^ (((ob >> 9) & 1) << 5)); }
__host__ __device__ __forceinline__ void stage_rc(int b, int& R, int& C) { const int st = b / 1024, sb = b % 1024, swz = sb ^ (((sb >> 9) & 1) << 5); R = (st >> 1) * 16 + swz / 64; C = (st & 1) * 32 + (swz % 64) / 2; }
__host__ __device__ __forceinline__ int perm32(int rho) { const int n = rho >> 4, i = rho & 15; return 8 * (i >> 2) + 4 * n + (i & 3); }

struct Unit { int pm, pn; const char* A; const char* B; };

__device__ __forceinline__ unsigned cvt_pk_bf16(float lo, float hi) { unsigned r; asm volatile("v_cvt_pk_bf16_f32 %0, %1, %2" : "=v"(r) : "v"(lo), "v"(hi)); return r; }

template <class Epi, class Sched, bool ALIGN_EPI = false, bool SP2 = false, bool GATHER = false>
__device__ __forceinline__ void gemm_phase(PG8_LAS unsigned char* lds, const int K, const Sched& S, const Epi& E, const PG8_LAS int* gtab = nullptr) {
    const int tid = threadIdx.x, wid = __builtin_amdgcn_readfirstlane(tid >> 6), lane = tid & 63, wr = wid >> 2, wc = wid & 3, fr = lane & 15, fq = lane >> 4;
    const int nt = K / BK;
    unsigned voffA[2], voffB[2]; int gR[2]; unsigned gC[2];
#pragma unroll
    for (int i = 0; i < 2; ++i) { int R, C; stage_rc(tid * 16 + i * 8192, R, C); const int Rb = Epi::PERM ? ((R & ~31) + perm32(R & 31)) : R;
        voffA[i] = (unsigned)(R * K + C) * 2u; voffB[i] = (unsigned)(Rb * K + C) * 2u; gR[i] = R; gC[i] = (unsigned)C * 2u; }
    const size_t kstep = (size_t)(BK * 2);
    const size_t hstep = (size_t)HALF * K * 2;
    unsigned cvo0[2], cvo1[2], nvo0[2], nvo1[2];
#define PG8_GVO(V0, V1, ui_) do { _Pragma("unroll") for (int _i = 0; _i < 2; ++_i) { \
        if constexpr (GATHER) { V0[_i] = (unsigned)gtab[(ui_) * 256 + gR[_i]] * (unsigned)(K * 2) + gC[_i]; V1[_i] = (unsigned)gtab[(ui_) * 256 + 128 + gR[_i]] * (unsigned)(K * 2) + gC[_i]; } \
        else { V0[_i] = voffA[_i]; V1[_i] = voffA[_i] + (unsigned)hstep; } } } while (0)
    const unsigned ldsw = (unsigned)wid * 1024u;
    const int aoff = lds_byte(wr * 64 + fr, fq * 8), boff = lds_byte(wc * 32 + fr, fq * 8);
#define PG8_SA(b, h) (((b) * 2 + (h)) * HTB)
#define PG8_SB(b, h) ((4 + (b) * 2 + (h)) * HTB)
#define PG8_STAGE(bufoff, gbase, voff) do { _Pragma("unroll") for (int _i = 0; _i < 2; ++_i) \
        __builtin_amdgcn_global_load_lds((const unsigned*)((const char*)(gbase) + (voff)[_i]), (PG8_LAS unsigned*)(lds + (bufoff) + ldsw + _i * 8192), 16, 0, 0); } while (0)
#define PG8_LDA(dst, b, h) do { _Pragma("unroll") for (int m = 0; m < 4; ++m) _Pragma("unroll") for (int k = 0; k < 2; ++k) dst[m][k] = *(const PG8_LAS bf16x8*)(lds + PG8_SA(b, h) + aoff + m * 2048 + k * 1024); } while (0)
#define PG8_LDB(dst, b, h) do { _Pragma("unroll") for (int n = 0; n < 2; ++n) _Pragma("unroll") for (int k = 0; k < 2; ++k) dst[n][k] = *(const PG8_LAS bf16x8*)(lds + PG8_SB(b, h) + boff + n * 2048 + k * 1024); } while (0)
#define PG8_MMA(ai, bj, At, Bt) do { __builtin_amdgcn_s_setprio(1); _Pragma("unroll") for (int m = 0; m < 4; ++m) _Pragma("unroll") for (int n = 0; n < 2; ++n) _Pragma("unroll") for (int k = 0; k < 2; ++k) \
        acc[ai][bj][m][n] = __builtin_amdgcn_mfma_f32_16x16x32_bf16(Bt[n][k], At[m][k], acc[ai][bj][m][n], 0, 0, 0); __builtin_amdgcn_s_setprio(0); } while (0)
#define PG8_WAIT_V(n) asm volatile("s_waitcnt vmcnt(" #n ")" ::: "memory")
#define PG8_WAIT_L(n) asm volatile("s_waitcnt lgkmcnt(" #n ")" ::: "memory")
#define PG8_BAR __builtin_amdgcn_s_barrier()
#define PG8_SCHED __builtin_amdgcn_sched_barrier(0)
    Unit cur, nxt; int ui = 0;
    if (!S.next(0, cur)) return;
    f32x4 acc[2][2][4][2];
#pragma unroll
    for (int a = 0; a < 2; ++a)
#pragma unroll
        for (int b = 0; b < 2; ++b)
#pragma unroll
            for (int m = 0; m < 4; ++m)
#pragma unroll
                for (int n = 0; n < 2; ++n) acc[a][b][m][n] = (f32x4){0.f, 0.f, 0.f, 0.f};
    bf16x8 At[4][2], B0[2][2], B1[2][2];
    const char* cA = cur.A; const char* cB = cur.B;
    PG8_GVO(cvo0, cvo1, 0);
    S.a_ready(cur);
    if constexpr (SP2) {
        PG8_STAGE(PG8_SB(0, 0), cB, voffB); PG8_STAGE(PG8_SB(0, 1), cB + hstep, voffB); PG8_STAGE(PG8_SA(0, 0), cA, cvo0); PG8_STAGE(PG8_SA(0, 1), cA, cvo1);
        if (wr == 1) PG8_BAR;
        PG8_WAIT_V(2); PG8_BAR;
        PG8_STAGE(PG8_SB(1, 0), cB + kstep, voffB); PG8_STAGE(PG8_SA(1, 0), cA + kstep, cvo0); PG8_STAGE(PG8_SB(1, 1), cB + hstep + kstep, voffB);
        PG8_WAIT_V(6); PG8_BAR;
    } else {
        PG8_STAGE(PG8_SB(0, 0), cB, voffB); PG8_STAGE(PG8_SA(0, 0), cA, cvo0); PG8_STAGE(PG8_SB(0, 1), cB + hstep, voffB); PG8_STAGE(PG8_SA(0, 1), cA, cvo1);
        if (wr == 1) PG8_BAR;
        PG8_WAIT_V(4); PG8_BAR;
        PG8_STAGE(PG8_SB(1, 0), cB + kstep, voffB); PG8_STAGE(PG8_SA(1, 0), cA + kstep, cvo0); PG8_STAGE(PG8_SB(1, 1), cB + hstep + kstep, voffB);
        PG8_WAIT_V(6); PG8_BAR;
    }
    for (;;) {
        const bool has_next = S.next(ui + 1, nxt);
        const char* nA = has_next ? nxt.A : cA; const char* nB = has_next ? nxt.B : cB;
        if (has_next) PG8_GVO(nvo0, nvo1, ui + 1); else { _Pragma("unroll") for (int _i = 0; _i < 2; ++_i) { nvo0[_i] = cvo0[_i]; nvo1[_i] = cvo1[_i]; } }
        for (int t = 0; t < nt; t += 2) {
            const bool last = (t == nt - 2);
            const char* a1 = cA + (size_t)(t + 1) * kstep;
            const char* a2 = last ? nA : cA + (size_t)(t + 2) * kstep; const char* b2 = last ? nB : cB + (size_t)(t + 2) * kstep;
            const char* a3 = a2 + kstep; const char* b3 = b2 + kstep;
            unsigned x0[2], x1[2];
            _Pragma("unroll") for (int _i = 0; _i < 2; ++_i) { x0[_i] = last ? nvo0[_i] : cvo0[_i]; x1[_i] = last ? nvo1[_i] : cvo1[_i]; }
            if (last && has_next) S.a_ready(nxt);
            if constexpr (SP2) {
            PG8_LDB(B0, 0, 0); PG8_LDB(B1, 0, 1); PG8_SCHED; PG8_LDA(At, 0, 0); PG8_STAGE(PG8_SA(1, 1), a1, cvo1);
            PG8_WAIT_V(8); PG8_WAIT_L(0); PG8_BAR; PG8_MMA(0, 0, At, B0); PG8_MMA(0, 1, At, B1); PG8_BAR; PG8_SCHED;
            PG8_LDA(At, 0, 1); PG8_STAGE(PG8_SB(0, 0), b2, voffB); PG8_STAGE(PG8_SB(0, 1), b2 + hstep, voffB); PG8_STAGE(PG8_SA(0, 0), a2, x0);
            PG8_WAIT_V(8); PG8_WAIT_L(0); PG8_BAR; PG8_MMA(1, 0, At, B0); PG8_MMA(1, 1, At, B1); PG8_BAR; PG8_SCHED;
            PG8_LDB(B0, 1, 0); PG8_LDB(B1, 1, 1); PG8_SCHED; PG8_LDA(At, 1, 0); PG8_STAGE(PG8_SA(0, 1), a2, x1);
            PG8_WAIT_V(8); PG8_WAIT_L(0); PG8_BAR; PG8_MMA(0, 0, At, B0); PG8_MMA(0, 1, At, B1); PG8_BAR; PG8_SCHED;
            PG8_LDA(At, 1, 1); PG8_STAGE(PG8_SB(1, 0), b3, voffB); PG8_STAGE(PG8_SB(1, 1), b3 + hstep, voffB); PG8_STAGE(PG8_SA(1, 0), a3, x0);
            PG8_WAIT_V(8); PG8_WAIT_L(0); PG8_BAR; PG8_MMA(1, 0, At, B0); PG8_MMA(1, 1, At, B1); PG8_BAR; PG8_SCHED;
            } else {
            PG8_LDB(B0, 0, 0); PG8_SCHED; PG8_LDA(At, 0, 0); PG8_STAGE(PG8_SA(1, 1), a1, cvo1);
            PG8_WAIT_L(8); PG8_BAR; PG8_WAIT_L(0); PG8_MMA(0, 0, At, B0); PG8_BAR; PG8_SCHED;
            PG8_LDB(B1, 0, 1); PG8_STAGE(PG8_SB(0, 0), b2, voffB);
            PG8_BAR; PG8_WAIT_L(0); PG8_MMA(0, 1, At, B1); PG8_BAR;
            PG8_LDA(At, 0, 1); PG8_STAGE(PG8_SA(0, 0), a2, x0);
            PG8_BAR; PG8_WAIT_L(0); PG8_MMA(1, 0, At, B0); PG8_BAR; PG8_SCHED;
            PG8_STAGE(PG8_SB(0, 1), b2 + hstep, voffB);
            PG8_WAIT_V(6); PG8_BAR; PG8_MMA(1, 1, At, B1); PG8_BAR;
            PG8_LDB(B0, 1, 0); PG8_SCHED; PG8_LDA(At, 1, 0); PG8_STAGE(PG8_SA(0, 1), a2, x1);
            PG8_WAIT_L(8); PG8_BAR; PG8_WAIT_L(0); PG8_MMA(0, 0, At, B0); PG8_BAR; PG8_SCHED;
            PG8_LDB(B1, 1, 1); PG8_STAGE(PG8_SB(1, 0), b3, voffB);
            PG8_BAR; PG8_WAIT_L(0); PG8_MMA(0, 1, At, B1); PG8_BAR;
            PG8_LDA(At, 1, 1); PG8_STAGE(PG8_SA(1, 0), a3, x0);
            PG8_BAR; PG8_WAIT_L(0); PG8_MMA(1, 0, At, B0); PG8_BAR; PG8_SCHED;
            PG8_STAGE(PG8_SB(1, 1), b3 + hstep, voffB);
            PG8_WAIT_V(6); PG8_BAR; PG8_MMA(1, 1, At, B1); PG8_BAR;
            }
        }
        if constexpr (ALIGN_EPI) { if (wr == 0) PG8_BAR; }
        if constexpr (!Epi::AFTER_DRAIN) { E(acc, cur, wr, wc, fr, fq); S.done(cur); }
        if (!has_next) break;
#pragma unroll
        for (int a = 0; a < 2; ++a)
#pragma unroll
            for (int b = 0; b < 2; ++b)
#pragma unroll
                for (int m = 0; m < 4; ++m)
#pragma unroll
                    for (int n = 0; n < 2; ++n) acc[a][b][m][n] = (f32x4){0.f, 0.f, 0.f, 0.f};
        cur = nxt; cA = nA; cB = nB; ++ui;
        _Pragma("unroll") for (int _i = 0; _i < 2; ++_i) { cvo0[_i] = nvo0[_i]; cvo1[_i] = nvo1[_i]; }
        if constexpr (ALIGN_EPI) { if (wr == 1) PG8_BAR; }
    }
    PG8_WAIT_V(0);
    if constexpr (!ALIGN_EPI) { if (wr == 0) PG8_BAR; }
    PG8_BAR;
    if constexpr (Epi::AFTER_DRAIN) { E.fused(acc, cur, wr, wc, fr, fq, lds, wid, lane); S.done(cur); }
#undef PG8_GVO
#undef PG8_SA
#undef PG8_SB
#undef PG8_STAGE
#undef PG8_LDA
#undef PG8_LDB
#undef PG8_MMA
#undef PG8_WAIT_V
#undef PG8_WAIT_L
#undef PG8_BAR
#undef PG8_SCHED
}
}

constexpr int NWAVES = 8;
constexpr int D = 1024, SEQ = 16384, NBATCH = 2, NMETA = 16;
constexpr int NREAL = NBATCH * SEQ;
constexpr int NTOK0 = NREAL + NMETA;
constexpr int MP = 33024;
constexpr int LP = 16448;
constexpr int NE = 16, DE = 512;
constexpr float ALPHA = 1.4142135623730951f, LN_EPS = 1e-5f;
constexpr float LAM_INIT = 0.35550906759096934f;
constexpr float C2 = 0.18033688011112042f;
constexpr float LOG2E = 1.4426950408889634f;

constexpr size_t MiB = 1u << 20, KiB = 1024;
constexpr size_t WS_CTL = 0, CTL_ZERO_BYTES = 1 * MiB;
constexpr size_t WS_ROPE = 1 * MiB;
constexpr size_t WS_METAH = 3 * MiB;
constexpr size_t WS_ROUTE_E = 3 * MiB + 64 * KiB;
constexpr size_t WS_ROUTE_W = 3 * MiB + 256 * KiB;
constexpr size_t WS_ROUTE_P = 3 * MiB + 576 * KiB;
constexpr size_t WS_WB = 4 * MiB;
constexpr size_t WS_BCNT = 4 * MiB + 128 * KiB;
constexpr size_t WS_TSTART = 4 * MiB + 192 * KiB;
constexpr size_t WS_WPW1 = 9 * MiB, WS_WPW2 = 13 * MiB, WS_WQKV = 15 * MiB, WS_WO = 21 * MiB;
constexpr size_t WS_W13 = 23 * MiB, WS_W2T = 55 * MiB;
constexpr size_t WS_W13B = 202 * MiB, WS_W2TB = 234 * MiB;
constexpr size_t WS_A = 72 * MiB;
constexpr size_t WS_R1 = 137 * MiB;
constexpr size_t WS_R2 = 274 * MiB;
constexpr size_t WS_R3 = 343 * MiB;
constexpr size_t WS_K = WS_R3 + 65 * MiB;
constexpr size_t WS_END = 480 * MiB;
constexpr int CW_KMAX = 1024;
constexpr int CW_BAR = 4096;
constexpr int CW_ROWIDX = 131072;
constexpr int GTAB_OFF = 132096;

constexpr int RING_OFF = 0, RING_BYTES = 131072;
constexpr int LDSCTL_OFF = RING_BYTES, MISC_OFF = LDSCTL_OFF + 320;
constexpr int LDS_BYTES = 147456;

#define GAS __attribute__((address_space(1)))
#define LAS __attribute__((address_space(3)))
typedef unsigned short bf16;
typedef unsigned v4u __attribute__((ext_vector_type(4)));
typedef unsigned v2u __attribute__((ext_vector_type(2)));
typedef float f32x4 __attribute__((ext_vector_type(4)));
typedef float f32x2 __attribute__((ext_vector_type(2)));
typedef float f32x16 __attribute__((ext_vector_type(16)));
typedef short bf16x8 __attribute__((ext_vector_type(8)));
typedef short s16x4 __attribute__((ext_vector_type(4)));
typedef GAS unsigned gu32;
#define RLX_AGENT __ATOMIC_RELAXED, __HIP_MEMORY_SCOPE_AGENT
#define LDS_WAIT() asm volatile("s_waitcnt lgkmcnt(0)" ::: "memory")
#define VM_WAIT() asm volatile("s_waitcnt vmcnt(0)" ::: "memory")
__device__ __forceinline__ unsigned f2bf(float f) { unsigned u = __builtin_bit_cast(unsigned, f); return (u + 0x7fffu + ((u >> 16) & 1u)) >> 16; }
typedef __bf16 bf16x2v __attribute__((ext_vector_type(2)));
__device__ __forceinline__ unsigned pk2(float lo, float hi) { f32x2 v = {lo, hi}; bf16x2v b = __builtin_convertvector(v, bf16x2v); return __builtin_bit_cast(unsigned, b); }
__device__ __forceinline__ float bflo(unsigned x) { return __builtin_bit_cast(float, x << 16); }
__device__ __forceinline__ float bfhi(unsigned x) { return __builtin_bit_cast(float, x & 0xffff0000u); }
__device__ __forceinline__ float fast_exp2(float x) { return __builtin_amdgcn_exp2f(x); }
__device__ __forceinline__ float fast_rcp(float x) { return __builtin_amdgcn_rcpf(x); }
__device__ __forceinline__ float sigmoidf_(float x) { return fast_rcp(1.0f + fast_exp2(-x * LOG2E)); }
__device__ __forceinline__ float wave_sum(float v) {
#pragma unroll
    for (int o = 1; o < 64; o <<= 1) v += __shfl_xor(v, o);
    return v;
}

#define XB_TMO      128
#define XB_XCNT(j)  (256  + 64 * (j))
#define XB_XSUB(j)  (1280 + 64 * (j))
#define XB_XGEN(j)  (2304 + 64 * (j))
#define XB_TOP      3328
#define XB_TOPGEN   3392
#define XCD_BAR_WORDS 3456
#define XB_SPIN_CAP (1u << 20)

__device__ __forceinline__ unsigned xb_ld(unsigned* p)              { return __hip_atomic_load(p, __ATOMIC_RELAXED, __HIP_MEMORY_SCOPE_AGENT); }
__device__ __forceinline__ unsigned xb_add(unsigned* p, unsigned v) { return __hip_atomic_fetch_add(p, v, __ATOMIC_RELAXED, __HIP_MEMORY_SCOPE_AGENT); }
__device__ __forceinline__ unsigned xb_xcc_id() { return (unsigned)__builtin_amdgcn_s_getreg((3 << 11) | 20) & 0xFu; }
#define XB_SPIN(cond, bar) do { unsigned _sp = 0; while (cond) { __builtin_amdgcn_s_sleep(1); \
    if ((++_sp & 255u) == 0u) { if (xb_ld(&(bar)[XB_TMO])) break; if (_sp > XB_SPIN_CAP) { atomicAdd(&(bar)[XB_TMO], 1u); break; } } } } while (0)

struct XcdBarrier {
    unsigned* bar; unsigned x;
    volatile LAS unsigned* st;
};

__device__ __forceinline__ XcdBarrier xcd_barrier_post(unsigned* bar, volatile LAS unsigned* st) {
    XcdBarrier b; b.bar = bar; b.x = xb_xcc_id(); b.st = st;
    if (threadIdx.x == 0) (void)xb_add(&bar[XB_XCNT(b.x)], 1u);
    return b;
}
__device__ __forceinline__ void xcd_barrier_complete(unsigned* bar, unsigned x, unsigned& nloc, unsigned& nx) {
    const unsigned G = gridDim.x * gridDim.y * gridDim.z;
    unsigned sum, cnt, mine, sp = 0u;
    for (;;) {
        sum = 0u; cnt = 0u; mine = 0u;
#pragma unroll
        for (unsigned j = 0; j < 16; ++j) { const unsigned c = xb_ld(&bar[XB_XCNT(j)]); sum += c; cnt += (c > 0u) ? 1u : 0u; mine = (j == x) ? c : mine; }
        if (sum == G) break;
        __builtin_amdgcn_s_sleep(1);
        if ((++sp & 255u) == 0u) { if (xb_ld(&bar[XB_TMO])) break; if (sp > XB_SPIN_CAP) { atomicAdd(&bar[XB_TMO], 1u); break; } }
    }
    nloc = mine > 0u ? mine : 1u; nx = cnt > 0u ? cnt : 1u;
}

__device__ __forceinline__ void xcd_barrier(const XcdBarrier& b) {
    asm volatile("s_waitcnt vmcnt(0)" ::: "memory");
    __syncthreads();
    if (threadIdx.x == 0) {
        unsigned* bar = b.bar;
        __builtin_amdgcn_s_waitcnt(0);
        unsigned nloc = b.st[0], nx = b.st[1];
        if (nloc == 0u) { xcd_barrier_complete(bar, b.x, nloc, nx); b.st[0] = nloc; b.st[1] = nx; }
        const unsigned old = xb_add(&bar[XB_XSUB(b.x)], 1u);
        const unsigned gen = old / nloc;
        if (old + 1u == (gen + 1u) * nloc) {
            __builtin_amdgcn_fence(__ATOMIC_RELEASE, "agent");
            asm volatile("s_waitcnt vmcnt(0)" ::: "memory");
            const unsigned og = xb_add(&bar[XB_TOP], 1u);
            const unsigned tg = og / nx;
            if (og + 1u == (tg + 1u) * nx) xb_add(&bar[XB_TOPGEN], 1u);
            else XB_SPIN(xb_ld(&bar[XB_TOPGEN]) == tg, bar);
            __builtin_amdgcn_fence(__ATOMIC_ACQUIRE, "agent");
            xb_add(&bar[XB_XGEN(b.x)], 1u);
            asm volatile("s_waitcnt vmcnt(0)" ::: "memory");
        } else {
            XB_SPIN(xb_ld(&bar[XB_XGEN(b.x)]) == gen, bar);
            __builtin_amdgcn_fence(__ATOMIC_ACQUIRE, "agent");
            asm volatile("s_waitcnt vmcnt(0)" ::: "memory");
        }
    }
    __syncthreads();
}

struct Frame {
    LAS unsigned char* lds;
    volatile LAS unsigned* MISC;
    gu32* ctl;
    unsigned char* ws;
    int tid, lane, wave;
    int vcu, G;
    const float* in[28];
    float* out;
};
__device__ __forceinline__ float* hrow(const Frame& F, int r) { return r < NREAL ? F.out + (size_t)r * D : (float*)(F.ws + WS_METAH) + (size_t)(r - NREAL) * D; }
__device__ __forceinline__ const float* h0row(const Frame& F, int r) { return r < NREAL ? F.in[0] + (size_t)r * D : F.in[1] + (size_t)(r - NREAL) * D; }

struct DenseOrder {
    const char* A; const char* Bt; size_t tstep; int nM, nN, nwg, G, c;
    __device__ __forceinline__ void init(const void* A_, const void* Bt_, int K, int nM_, int nN_, int G_, int c_) {
        A = (const char*)A_; Bt = (const char*)Bt_; tstep = (size_t)256 * K * 2; nM = nM_; nN = nN_; nwg = nM * nN; G = G_; c = c_; }
    __device__ __forceinline__ bool map(int i, int& pm, int& pn) const {
        const long L = (long)i * G + c; if (L >= nwg) return false;
        int wgid = (int)L; { const int q = nwg / 8, r = nwg % 8, xcd = wgid % 8, off = wgid / 8; wgid = (xcd < r ? xcd * (q + 1) : r * (q + 1) + (xcd - r) * q) + off; }
        const int nig = 8 * nN, gid = wgid / nig, fm = gid * 8, gsz = (nM - fm) < 8 ? (nM - fm) : 8;
        pm = fm + ((wgid % nig) % gsz); pn = (wgid % nig) / gsz; return true;
    }
    __device__ __forceinline__ bool next(int i, pg8::Unit& u) const {
        if (!map(i, u.pm, u.pn)) return false;
        u.A = A + (size_t)u.pm * tstep; u.B = Bt + (size_t)u.pn * tstep; return true; }
    __device__ __forceinline__ void a_ready(const pg8::Unit&) const {}
    __device__ __forceinline__ void done(const pg8::Unit&) const {}
};
struct MoeOrder {
    DenseOrder d; size_t estep; int ts[17]; bool gather;
    __device__ __forceinline__ void init(const void* A_, const void* Bt_, int K, int nN_, size_t estep_, const int* tstart, int G_, int c_) {
#pragma unroll
        for (int e = 0; e < 17; ++e) ts[e] = __builtin_amdgcn_readfirstlane(tstart[e]);
        d.init(A_, Bt_, K, ts[16], nN_, G_, c_); estep = estep_; gather = false; }
    __device__ __forceinline__ bool next(int i, pg8::Unit& u) const {
        if (!d.map(i, u.pm, u.pn)) return false;
        int e = 0;
#pragma unroll
        for (int k = 1; k < 16; ++k) e += (u.pm >= ts[k]) ? 1 : 0;
        u.A = gather ? d.A : d.A + (size_t)u.pm * d.tstep; u.B = d.Bt + (size_t)e * estep + (size_t)u.pn * d.tstep; return true; }
    __device__ __forceinline__ void a_ready(const pg8::Unit&) const {}
    __device__ __forceinline__ void done(const pg8::Unit&) const {}
};

using pg8::Unit;
struct EpiGLU {
    static constexpr bool PERM = true, AFTER_DRAIN = false;
    bf16* U; const float* bias;
    __device__ __forceinline__ void operator()(const f32x4 (&acc)[2][2][4][2], const Unit& u, int wr, int wc, int fr, int fq) const {
        const int row0 = u.pm * 256 + wr * 64 + fr, oc = u.pn * 128 + wc * 32 + 8 * fq;
        f32x4 ba[2], bg[2];
#pragma unroll
        for (int n = 0; n < 2; ++n) { ba[n] = *(const f32x4*)(bias + oc + 4 * n); bg[n] = *(const f32x4*)(bias + D + oc + 4 * n); }
#pragma unroll
        for (int ai = 0; ai < 2; ++ai)
#pragma unroll
            for (int m = 0; m < 4; ++m) {
                float o[8];
#pragma unroll
                for (int n = 0; n < 2; ++n)
#pragma unroll
                    for (int i = 0; i < 4; ++i) { const float a = acc[ai][0][m][n][i] + ba[n][i], g = acc[ai][1][m][n][i] + bg[n][i]; o[4 * n + i] = a * sigmoidf_(g); }
                v4u w; w.x = pk2(o[0], o[1]); w.y = pk2(o[2], o[3]); w.z = pk2(o[4], o[5]); w.w = pk2(o[6], o[7]);
                *(v4u*)(U + (size_t)(row0 + ai * 128 + m * 16) * D + oc) = w;
            }
    }
};
struct EpiSwiGLU {
    static constexpr bool PERM = true, AFTER_DRAIN = false;
    bf16* H;
    __device__ __forceinline__ void operator()(const f32x4 (&acc)[2][2][4][2], const Unit& u, int wr, int wc, int fr, int fq) const {
        const int row0 = u.pm * 256 + wr * 64 + fr, oc = u.pn * 128 + wc * 32 + 8 * fq;
#pragma unroll
        for (int ai = 0; ai < 2; ++ai)
#pragma unroll
            for (int m = 0; m < 4; ++m) {
                float o[8];
#pragma unroll
                for (int n = 0; n < 2; ++n)
#pragma unroll
                    for (int i = 0; i < 4; ++i) { const float a = acc[ai][0][m][n][i], g = acc[ai][1][m][n][i]; o[4 * n + i] = a * sigmoidf_(a) * g; }
                v4u w; w.x = pk2(o[0], o[1]); w.y = pk2(o[2], o[3]); w.z = pk2(o[4], o[5]); w.w = pk2(o[6], o[7]);
                *(v4u*)(H + (size_t)(row0 + ai * 128 + m * 16) * DE + oc) = w;
            }
    }
};
struct EpiBf16 {
    static constexpr bool PERM = true, AFTER_DRAIN = false;
    bf16* O; const float* bias;
    __device__ __forceinline__ void operator()(const f32x4 (&acc)[2][2][4][2], const Unit& u, int wr, int wc, int fr, int fq) const {
        const int row0 = u.pm * 256 + wr * 64 + fr, oc = u.pn * 256 + wc * 32 + 8 * fq;
        f32x4 bv[2][2];
#pragma unroll
        for (int bj = 0; bj < 2; ++bj)
#pragma unroll
            for (int n = 0; n < 2; ++n) bv[bj][n] = bias ? *(const f32x4*)(bias + oc + bj * 128 + 4 * n) : (f32x4){0.f, 0.f, 0.f, 0.f};
#pragma unroll
        for (int ai = 0; ai < 2; ++ai)
#pragma unroll
            for (int m = 0; m < 4; ++m)
#pragma unroll
                for (int bj = 0; bj < 2; ++bj) {
                    const f32x4 v0 = acc[ai][bj][m][0] + bv[bj][0], v1 = acc[ai][bj][m][1] + bv[bj][1];
                    v4u w; w.x = pk2(v0[0], v0[1]); w.y = pk2(v0[2], v0[3]); w.z = pk2(v1[0], v1[1]); w.w = pk2(v1[2], v1[3]);
                    *(v4u*)(O + (size_t)(row0 + ai * 128 + m * 16) * D + oc + bj * 128) = w;
                }
    }
};
template <bool LAYER0> struct EpiResF32 {
    static constexpr bool PERM = false, AFTER_DRAIN = false;
    float* Y; const float* bias; const float* hreal; const float* hmeta; int nvalid;
    __device__ __forceinline__ void operator()(const f32x4 (&acc)[2][2][4][2], const Unit& u, int wr, int wc, int fr, int fq) const {
        const int row0 = u.pm * 256 + wr * 64 + fr, c0 = u.pn * 256 + wc * 32 + 4 * fq;
        f32x4 bv[2][2];
#pragma unroll
        for (int bj = 0; bj < 2; ++bj)
#pragma unroll
            for (int n = 0; n < 2; ++n) bv[bj][n] = bias ? *(const f32x4*)(bias + c0 + bj * 128 + n * 16) : (f32x4){0.f, 0.f, 0.f, 0.f};
#pragma unroll
        for (int ai = 0; ai < 2; ++ai)
#pragma unroll
            for (int m = 0; m < 4; ++m) {
                const int r = row0 + ai * 128 + m * 16;
                if (r < nvalid) {
                    const float* hp = (r < NREAL ? hreal + (size_t)r * D : hmeta + (size_t)(r - NREAL) * D) + c0;
                    float* yp = Y + (size_t)r * D + c0;
#pragma unroll
                    for (int bj = 0; bj < 2; ++bj)
#pragma unroll
                        for (int n = 0; n < 2; ++n) { const f32x4 h = *(const f32x4*)(hp + bj * 128 + n * 16); *(f32x4*)(yp + bj * 128 + n * 16) = acc[ai][bj][m][n] + bv[bj][n] + ALPHA * h; }
                }
            }
    }
};
struct EpiQKV {
    static constexpr bool PERM = true, AFTER_DRAIN = false;
    bf16* Q; bf16* Kb; bf16* Vb; const f32x4* rope; unsigned* kmax;
    __device__ __forceinline__ void operator()(const f32x4 (&acc)[2][2][4][2], const Unit& u, int wr, int wc, int fr, int fq) const {
        const int kind = u.pn >> 2;
        const int cb = (u.pn & 3) * 256 + wc * 32 + 8 * fq;
        const bool meta = (u.pm == 128);
        const int b = u.pm >> 6;
        const bool ropew = (kind != 1) && ((wc & 1) == 0), dorope = ropew && (fq < 2);
        float nmax[2] = {0.f, 0.f};
        f32x4 csv[2][4][2];
#define QKV_ROPE_LOAD(ai_) do { if (ropew) { _Pragma("unroll") for (int m_ = 0; m_ < 4; ++m_) { \
            const int r_ = u.pm * 256 + (ai_) * 128 + wr * 64 + m_ * 16 + fr; \
            int pos_ = meta ? (r_ - NREAL) : NMETA + (r_ & (SEQ - 1)); \
            if (meta && (r_ - NREAL) >= NMETA) pos_ = 0; \
            csv[ai_][m_][0] = rope[(size_t)pos_ * 4 + 2 * (fq & 1)]; csv[ai_][m_][1] = rope[(size_t)pos_ * 4 + 2 * (fq & 1) + 1]; } } } while (0)
        QKV_ROPE_LOAD(0);
#pragma unroll
        for (int ai = 0; ai < 2; ++ai)
#pragma unroll
            for (int m = 0; m < 4; ++m) {
                if (ai == 0 && m == 2) QKV_ROPE_LOAD(1);
                const int r = u.pm * 256 + ai * 128 + wr * 64 + m * 16 + fr;
                const bool valid = !meta || (r - NREAL) < NMETA;
                int pos = meta ? (r - NREAL) : NMETA + (r & (SEQ - 1));
                if (!valid) pos = 0;
                f32x4 v[2][2];
#pragma unroll
                for (int bj = 0; bj < 2; ++bj)
#pragma unroll
                    for (int n = 0; n < 2; ++n) v[bj][n] = acc[ai][bj][m][n];
                if (dorope) {
                    const f32x4 cs0 = csv[ai][m][0], cs1 = csv[ai][m][1];
                    const float cc[4] = {cs0[0], cs0[2], cs1[0], cs1[2]}, ss[4] = {cs0[1], cs0[3], cs1[1], cs1[3]};
#pragma unroll
                    for (int bj = 0; bj < 2; ++bj)
#pragma unroll
                        for (int i = 0; i < 4; ++i) { const float t1 = v[bj][0][i], t2 = v[bj][1][i]; v[bj][0][i] = t1 * cc[i] - t2 * ss[i]; v[bj][1][i] = t1 * ss[i] + t2 * cc[i]; }
                }
                if (kind == 0) {
#pragma unroll
                    for (int bj = 0; bj < 2; ++bj) {
                        float ps = 0.f;
#pragma unroll
                        for (int n = 0; n < 2; ++n)
#pragma unroll
                            for (int i = 0; i < 4; ++i) ps += v[bj][n][i] * v[bj][n][i];
                        ps += __shfl_xor(ps, 16); ps += __shfl_xor(ps, 32);
                        if (valid) nmax[bj] = fmaxf(nmax[bj], ps);
                    }
                }
                const float sc = (kind == 2) ? C2 : 1.0f;
#pragma unroll
                for (int bj = 0; bj < 2; ++bj) {
                    const f32x4 v0 = v[bj][0] * sc, v1 = v[bj][1] * sc;
                    v4u w; w.x = pk2(v0[0], v0[1]); w.y = pk2(v0[2], v0[3]); w.z = pk2(v1[0], v1[1]); w.w = pk2(v1[2], v1[3]);
                    const int col = cb + bj * 128;
                    if (kind == 2) { if (!meta) *(v4u*)(Q + (size_t)r * D + col) = w; }
                    else {
                        bf16* dst = (kind == 0) ? Kb : Vb;
                        if (!meta) *(v4u*)(dst + ((size_t)b * LP + 64 + (r & (SEQ - 1))) * D + col) = w;
                        else if (valid) { const int pp = 48 + (r - NREAL); *(v4u*)(dst + (size_t)pp * D + col) = w; *(v4u*)(dst + ((size_t)LP + pp) * D + col) = w; }
                    }
                }
            }
        if (kind == 0) {
#pragma unroll
            for (int bj = 0; bj < 2; ++bj) {
                float mx = nmax[bj];
                mx = fmaxf(mx, __shfl_xor(mx, 1)); mx = fmaxf(mx, __shfl_xor(mx, 2)); mx = fmaxf(mx, __shfl_xor(mx, 4)); mx = fmaxf(mx, __shfl_xor(mx, 8));
                if ((threadIdx.x & 63) == 0) {
                    const int hc = ((u.pn & 3) * 256 + bj * 128 + wc * 32) >> 6, hf = wc & 1;
                    const unsigned bits = __builtin_bit_cast(unsigned, mx);
                    if (!meta) atomicMax(kmax + (b * 16 + hc) * 2 + hf, bits);
                    else { atomicMax(kmax + (0 * 16 + hc) * 2 + hf, bits); atomicMax(kmax + (1 * 16 + hc) * 2 + hf, bits); }
                }
            }
        }
    }
};
#undef QKV_ROPE_LOAD

__device__ __forceinline__ f32x4 mini_tile(const bf16* A16, const bf16* Bt, int brow0, int K, int lane) {
    const bf16* ap = A16 + (size_t)(lane & 15) * K + 8 * (lane >> 4);
    const bf16* bp = Bt + (size_t)(brow0 + (lane & 15)) * K + 8 * (lane >> 4);
    f32x4 acc = {0.f, 0.f, 0.f, 0.f};
#pragma unroll 8
    for (int k0 = 0; k0 < K; k0 += 32) { const bf16x8 a = *(const bf16x8*)(ap + k0), b = *(const bf16x8*)(bp + k0); acc = __builtin_amdgcn_mfma_f32_16x16x32_bf16(a, b, acc, 0, 0, 0); }
    return acc;
}
__device__ __forceinline__ void mini_glu(Frame& F) {
    const int tix = blockIdx.x * NWAVES + F.wave; if (tix >= 64) return;
    const bf16* A16 = (const bf16*)(F.ws + WS_A) + (size_t)NREAL * D; const bf16* Bt = (const bf16*)(F.ws + WS_WPW1); bf16* U = (bf16*)(F.ws + WS_R2);
    const int c = 16 * tix + (F.lane & 15), ra = 256 * (c >> 7) + (c & 127) - (F.lane & 15);
    const f32x4 aa = mini_tile(A16, Bt, ra, D, F.lane), ag = mini_tile(A16, Bt, ra + 128, D, F.lane);
    const float ba = F.in[3][c], bg = F.in[3][D + c];
#pragma unroll
    for (int i = 0; i < 4; ++i) { const int row = NREAL + 4 * (F.lane >> 4) + i; U[(size_t)row * D + c] = (bf16)f2bf((aa[i] + ba) * sigmoidf_(ag[i] + bg)); }
}
__device__ __forceinline__ void mini_pw2(Frame& F) {
    const int tix = blockIdx.x * NWAVES + F.wave; if (tix >= 64) return;
    const bf16* A16 = (const bf16*)(F.ws + WS_R3) + (size_t)NREAL * D; const bf16* Bt = (const bf16*)(F.ws + WS_WPW2); bf16* Y = (bf16*)(F.ws + WS_R1);
    const int c = 16 * tix + (F.lane & 15);
    const f32x4 a = mini_tile(A16, Bt, 16 * tix, D, F.lane);
    const float bb = F.in[9][c];
#pragma unroll
    for (int i = 0; i < 4; ++i) { const int j = 4 * (F.lane >> 4) + i; Y[(size_t)(NREAL + j) * D + c] = (bf16)f2bf(a[i] + bb); }
}
__device__ __forceinline__ void mini_kv(Frame& F) {
    const int tix = blockIdx.x * NWAVES + F.wave; if (tix >= 128) return;
    const bf16* A16 = (const bf16*)(F.ws + WS_A) + (size_t)NREAL * D; const bf16* Bt = (const bf16*)(F.ws + WS_WQKV);
    const int isv = tix >> 6, t = tix & 63, p = F.lane & 15, c = 16 * t + p;
    f32x4 a = mini_tile(A16, Bt, isv * D + 16 * t, D, F.lane);
    bf16* dst = (bf16*)(F.ws + (isv ? WS_R1 : WS_K));
    if (!isv) {
        if ((t & 3) == 0) {
            const f32x2* rope = (const f32x2*)(F.ws + WS_ROPE);
            const int jj = (p & 3) + 4 * (p >> 3);
#pragma unroll
            for (int i = 0; i < 4; ++i) { const int pos = 4 * (F.lane >> 4) + i; const f32x2 cs = rope[pos * 8 + jj];
                const float own = a[i], oth = __shfl_xor(own, 4);
                a[i] = (p & 4) ? (oth * cs.y + own * cs.x) : (own * cs.x - oth * cs.y); }
        }
        float mx = 0.f;
#pragma unroll
        for (int i = 0; i < 4; ++i) { float ps = a[i] * a[i]; ps += __shfl_xor(ps, 1); ps += __shfl_xor(ps, 2); ps += __shfl_xor(ps, 4); ps += __shfl_xor(ps, 8); mx = fmaxf(mx, ps); }
        mx = fmaxf(mx, __shfl_xor(mx, 16)); mx = fmaxf(mx, __shfl_xor(mx, 32));
        if (F.lane == 0) {
            const unsigned bits = __builtin_bit_cast(unsigned, 2.0f * mx); unsigned* kmax = (unsigned*)(F.ctl + CW_KMAX);
            const int hc = t >> 2, hf = (t >> 1) & 1;
            atomicMax(kmax + (0 * 16 + hc) * 2 + hf, bits); atomicMax(kmax + (1 * 16 + hc) * 2 + hf, bits);
        }
    }
#pragma unroll
    for (int i = 0; i < 4; ++i) { const int pp = 48 + 4 * (F.lane >> 4) + i; const bf16 v = (bf16)f2bf(a[i]); dst[(size_t)pp * D + c] = v; dst[((size_t)LP + pp) * D + c] = v; }
}

template <class RowMap>
__device__ __forceinline__ void transpose_item(const float* W, int K, int N, bf16* WT, const RowMap& rm, LAS float* scr, int item, int lane) {
    const int nblk = N / 32, kb = item / nblk, nb = item % nblk, k0 = 64 * kb, n0 = 32 * nb;
#pragma unroll 8
    for (int i = 0; i < 32; ++i) { const int kk = 2 * i + (lane >> 5); scr[kk * 33 + (lane & 31)] = W[(size_t)(k0 + kk) * N + n0 + (lane & 31)]; }
    LDS_WAIT(); asm volatile("" ::: "memory");
    const int c = lane & 7;
#pragma unroll
    for (int j = 0; j < 4; ++j) { const int n = (lane >> 3) + 8 * j; const LAS float* s = scr + (8 * c) * 33 + n;
        v4u o; o.x = pk2(s[0 * 33], s[1 * 33]); o.y = pk2(s[2 * 33], s[3 * 33]); o.z = pk2(s[4 * 33], s[5 * 33]); o.w = pk2(s[6 * 33], s[7 * 33]);
        *(GAS v4u*)(WT + (size_t)rm(n0 + n) * K + k0 + 8 * c) = o; }
    LDS_WAIT(); asm volatile("" ::: "memory");
}
struct RmId { int off; __device__ __forceinline__ int operator()(int n) const { return off + n; } };
struct RmGlu { int half, part; __device__ __forceinline__ int operator()(int n) const { return 256 * (n >> 7) + 128 * part + (n & 127); } };
struct RmRope { int off; __device__ __forceinline__ int operator()(int n) const { const int dd = n & 63; int p = dd; if (dd >= 4 && dd < 8) p = dd + 4; else if (dd >= 8 && dd < 12) p = dd - 4; return off + (n & ~63) + p; } };

__device__ __forceinline__ void moe_weights_convert(Frame& F, int layer, int gw, int NGW) {
    LAS float* scr = (LAS float*)(F.lds + RING_OFF + F.wave * 16384);
    bf16* W13 = (bf16*)(F.ws + (layer ? WS_W13B : WS_W13)); bf16* W2T = (bf16*)(F.ws + (layer ? WS_W2TB : WS_W2T));
    constexpr int I13 = (D / 64) * (DE / 32), I2 = (DE / 64) * (D / 32);
    for (int it = gw; it < NE * (2 * I13 + I2); it += NGW) {
        const int e = it / (2 * I13 + I2); int r = it % (2 * I13 + I2);
        const size_t woff = ((size_t)layer * NE + e) * (size_t)D * DE;
        if (r < I13) { transpose_item(F.in[25] + woff, D, DE, W13 + (size_t)e * D * D, RmGlu{0, 0}, scr, r, F.lane); continue; } r -= I13;
        if (r < I13) { transpose_item(F.in[26] + woff, D, DE, W13 + (size_t)e * D * D, RmGlu{0, 1}, scr, r, F.lane); continue; } r -= I13;
        transpose_item(F.in[27] + woff, DE, D, W2T + (size_t)e * D * DE, RmId{0}, scr, r, F.lane);
    }
}
__device__ __forceinline__ void sincos_acc(float af, float& c, float& s) {
    const double a = (double)af;
    const double q = __builtin_rint(a * 0.63661977236758134308);
    const double y = (a - q * 1.57079632679489655800) - q * 6.123233995736766036e-17;
    const double y2 = y * y;
    double sp = 1.0 / 1307674368000.0; sp = sp * y2 - 1.0 / 6227020800.0; sp = sp * y2 + 1.0 / 39916800.0; sp = sp * y2 - 1.0 / 362880.0; sp = sp * y2 + 1.0 / 5040.0; sp = sp * y2 - 1.0 / 120.0; sp = sp * y2 + 1.0 / 6.0;
    const double sy = y - y * y2 * sp;
    double cp = 1.0 / 87178291200.0; cp = cp * y2 - 1.0 / 479001600.0; cp = cp * y2 + 1.0 / 3628800.0; cp = cp * y2 - 1.0 / 40320.0; cp = cp * y2 + 1.0 / 720.0; cp = cp * y2 - 1.0 / 24.0; cp = cp * y2 + 0.5;
    const double cy = 1.0 - y2 * cp;
    const int qi = ((int)q) & 3;
    const double sv = (qi == 0) ? sy : (qi == 1) ? cy : (qi == 2) ? -sy : -cy;
    const double cv = (qi == 0) ? cy : (qi == 1) ? -sy : (qi == 2) ? -cy : sy;
    c = (float)cv; s = (float)sv;
}
__device__ __forceinline__ void p0_prologue(Frame& F) {
    LAS float* scr = (LAS float*)(F.lds + RING_OFF + F.wave * 16384);
    const int gw = blockIdx.x * NWAVES + F.wave, NGW = F.G * NWAVES;
    bf16* Wpw1 = (bf16*)(F.ws + WS_WPW1); bf16* Wpw2 = (bf16*)(F.ws + WS_WPW2); bf16* Wqkv = (bf16*)(F.ws + WS_WQKV); bf16* Wo = (bf16*)(F.ws + WS_WO);
    constexpr int I_PW1 = (D / 64) * (2 * D / 32), I_SQ = (D / 64) * (D / 32);
    constexpr int NITEMS = I_PW1 + 5 * I_SQ;
    for (int it = gw; it < NITEMS; it += NGW) {
        int r = it;
        if (r < I_PW1) {
            const int nblk = 2 * D / 32, nb = r % nblk; const int part = (nb * 32) >= D ? 1 : 0;
            const int kb = r / nblk, nbl = nb - part * (D / 32);
            transpose_item(F.in[2] + part * D, D, 2 * D, Wpw1, RmGlu{0, part}, scr, kb * nblk + nbl, F.lane);
            continue; }
        r -= I_PW1;
        if (r < I_SQ) { transpose_item(F.in[8], D, D, Wpw2, RmId{0}, scr, r, F.lane); continue; } r -= I_SQ;
        if (r < I_SQ) { transpose_item(F.in[10], D, D, Wqkv, RmRope{0}, scr, r, F.lane); continue; } r -= I_SQ;
        if (r < I_SQ) { transpose_item(F.in[11], D, D, Wqkv, RmId{D}, scr, r, F.lane); continue; } r -= I_SQ;
        if (r < I_SQ) { transpose_item(F.in[12], D, D, Wqkv, RmRope{2 * D}, scr, r, F.lane); continue; } r -= I_SQ;
        transpose_item(F.in[18], D, D, Wo, RmId{0}, scr, r, F.lane);
    }
    moe_weights_convert(F, 0, gw, NGW);
    bf16* A = (bf16*)(F.ws + WS_A);
    for (int m = gw; m < MP; m += NGW) {
        GAS unsigned long long* o8 = (GAS unsigned long long*)(A + (size_t)m * D) + F.lane;
        if (m < NTOK0) {
            const GAS f32x4* xr = (const GAS f32x4*)h0row(F, m) + F.lane;
#pragma unroll
            for (int j = 0; j < 4; ++j) { const f32x4 v = xr[64 * j]; o8[64 * j] = (unsigned long long)pk2(v.x, v.y) | ((unsigned long long)pk2(v.z, v.w) << 32); }
        } else {
#pragma unroll
            for (int j = 0; j < 4; ++j) o8[64 * j] = 0ull;
        }
    }
    {
        const float inv[8] = {1.0f, 0.1939227432012558f, 0.03760603070259094f, 0.007292664609849453f, 0.0014142135623842478f, 0.00027424818836152554f, 5.318296098266728e-05f, 1.0313386155758053e-05f};
        f32x2* rope = (f32x2*)(F.ws + WS_ROPE);
        for (int idx = blockIdx.x * 512 + F.tid; idx < (SEQ + NMETA) * 8; idx += F.G * 512) {
            const int pos = idx >> 3, j = idx & 7;
            float iv = inv[0];
#pragma unroll
            for (int k = 1; k < 8; ++k) iv = (j == k) ? inv[k] : iv;
            const float ang = (float)pos * iv; float c, s; sincos_acc(ang, c, s);
            rope[idx] = (f32x2){c, s};
        }
    }
}

__device__ __forceinline__ unsigned conv_rowload(const bf16* U, int b, int ch, int pp) {
    const int pc = pp < 0 ? 0 : pp, row = pc < NMETA ? NREAL + pc : b * SEQ + pc - NMETA;
    const unsigned v = *(const unsigned*)(U + (size_t)row * D + ch);
    return pp < 0 ? 0u : v;
}
__device__ __forceinline__ void conv_phase(Frame& F) {
    const bf16* U = (const bf16*)(F.ws + WS_R2); bf16* C = (bf16*)(F.ws + WS_R3);
    const int tid = F.tid, ch = 2 * tid;
    float w0[31], w1[31];
#pragma unroll
    for (int k = 0; k < 31; ++k) { const f32x2 v = *(const f32x2*)(F.in[4] + (size_t)k * D + ch); w0[k] = v.x; w1[k] = v.y; }
    const f32x2 bdw = *(const f32x2*)(F.in[5] + ch), lg = *(const f32x2*)(F.in[6] + ch), lb = *(const f32x2*)(F.in[7] + ch);
    LAS float* red = (LAS float*)(F.lds + RING_OFF);
    LAS float* fin = (LAS float*)(F.lds + RING_OFF + 2048);
    const bool b5 = (F.lane & 32) != 0, b4 = (F.lane & 16) != 0, b3 = (F.lane & 8) != 0, b2 = (F.lane & 4) != 0, b1 = (F.lane & 2) != 0;
    for (int u = blockIdx.x; u < 257; u += F.G) {
        const bool mu = (u == 256);
        const int b = mu ? 0 : (u >> 7), posbase = mu ? 0 : NMETA + (u & 127) * 128, nblk = mu ? 1 : 8;
        unsigned in[46], nx[16];
#define CONV_ROWLOAD(pp) conv_rowload(U, b, ch, (pp))
#pragma unroll
        for (int i = 0; i < 30; ++i) in[i] = CONV_ROWLOAD(posbase - 30 + i);
#pragma unroll
        for (int i = 0; i < 16; ++i) nx[i] = CONV_ROWLOAD(posbase + i);
        for (int kb = 0; kb < nblk; ++kb) {
            const int p0 = posbase + 16 * kb;
#pragma unroll
            for (int i = 0; i < 16; ++i) in[30 + i] = nx[i];
            if (kb + 1 < nblk) {
#pragma unroll
                for (int i = 0; i < 16; ++i) nx[i] = CONV_ROWLOAD(p0 + 16 + i);
            }
            float f0[46], f1[46];
#pragma unroll
            for (int i = 0; i < 46; ++i) { f0[i] = bflo(in[i]); f1[i] = bfhi(in[i]); }
            float a0[16], a1[16];
#pragma unroll
            for (int o = 0; o < 16; ++o) { float x0 = bdw.x, x1 = bdw.y;
#pragma unroll
                for (int k = 0; k < 31; ++k) { x0 += w0[k] * f0[o + k]; x1 += w1[k] * f1[o + k]; }
                a0[o] = x0; a1[o] = x1; }
            float v16[16], v8[8], v4[4], v2[2], v1;
#pragma unroll
            for (int i = 0; i < 16; ++i) { const float sv = a0[i] + a1[i], qv = a0[i] * a0[i] + a1[i] * a1[i]; v16[i] = (b5 ? qv : sv) + __shfl_xor(b5 ? sv : qv, 32); }
#pragma unroll
            for (int i = 0; i < 8; ++i) v8[i] = (b4 ? v16[8 + i] : v16[i]) + __shfl_xor(b4 ? v16[i] : v16[8 + i], 16);
#pragma unroll
            for (int i = 0; i < 4; ++i) v4[i] = (b3 ? v8[4 + i] : v8[i]) + __shfl_xor(b3 ? v8[i] : v8[4 + i], 8);
#pragma unroll
            for (int i = 0; i < 2; ++i) v2[i] = (b2 ? v4[2 + i] : v4[i]) + __shfl_xor(b2 ? v4[i] : v4[2 + i], 4);
            v1 = (b1 ? v2[1] : v2[0]) + __shfl_xor(b1 ? v2[0] : v2[1], 2);
            v1 += __shfl_xor(v1, 1);
            if ((F.lane & 1) == 0) red[F.wave * 32 + (F.lane >> 1)] = v1;
            __syncthreads();
            if (tid < 32) { float t = 0.f;
#pragma unroll
                for (int w = 0; w < 8; ++w) t += red[w * 32 + tid];
                fin[tid] = t; }
            __syncthreads();
#pragma unroll
            for (int o = 0; o < 16; ++o) {
                const float mean = fin[o] * (1.0f / D), var = fmaxf(fin[16 + o] * (1.0f / D) - mean * mean, 0.f), rstd = __builtin_amdgcn_rsqf(var + LN_EPS);
                float y0 = (a0[o] - mean) * rstd * lg.x + lb.x, y1 = (a1[o] - mean) * rstd * lg.y + lb.y;
                y0 = y0 * sigmoidf_(y0); y1 = y1 * sigmoidf_(y1);
                const int pp = p0 + o, row = pp < NMETA ? NREAL + pp : b * SEQ + pp - NMETA;
                *(unsigned*)(C + (size_t)row * D + ch) = pk2(y0, y1);
            }
#pragma unroll
            for (int i = 0; i < 30; ++i) in[i] = in[i + 16];
        }
#undef CONV_ROWLOAD
    }
}

template <int LAYER> __device__ __forceinline__ void ln_route_phase(Frame& F, int nrows) {
    const bf16* Mx = (const bf16*)(F.ws + WS_R1); bf16* A = (bf16*)(F.ws + WS_A);
    unsigned* route_e = (unsigned*)(F.ws + WS_ROUTE_E); f32x2* route_w = (f32x2*)(F.ws + WS_ROUTE_W);
    LAS float* WL = (LAS float*)(F.lds + RING_OFF);
    LAS int* wcnt = (LAS int*)(F.lds + RING_OFF + 20 * 1024 * 4);
    const float* wg = F.in[21] + (size_t)LAYER * D * 4; const float* we = F.in[23] + (size_t)LAYER * D * 16;
    for (int idx = F.tid; idx < D * 4; idx += 512) WL[(idx & 3) * D + (idx >> 2)] = wg[idx];
    for (int idx = F.tid; idx < D * 16; idx += 512) WL[(4 + (idx & 15)) * D + (idx >> 4)] = we[idx];
    __syncthreads();
    const float* gp = F.in[19] + (size_t)(LAYER * 2 + 0) * D; const float* bp = F.in[20] + (size_t)(LAYER * 2 + 0) * D;
    f32x4 gam[4], bet[4];
#pragma unroll
    for (int j = 0; j < 4; ++j) { gam[j] = *(const f32x4*)(gp + F.lane * 4 + 256 * j); bet[j] = *(const f32x4*)(bp + F.lane * 4 + 256 * j); }
    float bgr[4], bex[16];
#pragma unroll
    for (int o = 0; o < 4; ++o) bgr[o] = F.in[22][LAYER * 4 + o];
#pragma unroll
    for (int o = 0; o < 16; ++o) bex[o] = F.in[24][LAYER * 16 + o];
    const int gw = blockIdx.x * NWAVES + F.wave, NGW = F.G * NWAVES;
    int cnt = 0;
    LAS float* ps = (LAS float*)(F.lds + RING_OFF + 82432) + F.wave * (4 * 68);
#define LNR_A(r_, V) do { \
        const GAS v2u* mr_ = (const GAS v2u*)(Mx + (size_t)(r_) * D) + F.lane; \
        const GAS f32x4* hin_ = (const GAS f32x4*)h0row(F, LAYER == 0 ? (r_) : 0) + F.lane; \
        const GAS v2u* hb_ = (const GAS v2u*)(A + (size_t)(r_) * D) + F.lane;     \
        float s_ = 0.f; \
        _Pragma("unroll") for (int j = 0; j < 4; ++j) { const v2u a = mr_[64 * j]; f32x4 h; \
            if (LAYER == 0) h = hin_[64 * j]; else { const v2u hb = hb_[64 * j]; h = (f32x4){bflo(hb.x), bfhi(hb.x), bflo(hb.y), bfhi(hb.y)}; } \
            V[j] = ALPHA * h + (f32x4){bflo(a.x), bfhi(a.x), bflo(a.y), bfhi(a.y)}; s_ += (V[j].x + V[j].y) + (V[j].z + V[j].w); } \
        const float mean_ = wave_sum(s_) * (1.f / D); float s2_ = 0.f; \
        _Pragma("unroll") for (int j = 0; j < 4; ++j) { V[j] = V[j] - mean_; s2_ += (V[j].x * V[j].x + V[j].y * V[j].y) + (V[j].z * V[j].z + V[j].w * V[j].w); } \
        const float rstd_ = __builtin_amdgcn_rsqf(wave_sum(s2_) * (1.f / D) + LN_EPS); \
        GAS unsigned long long* o8_ = (GAS unsigned long long*)(A + (size_t)(r_) * D) + F.lane; \
        _Pragma("unroll") for (int j = 0; j < 4; ++j) { V[j] = V[j] * rstd_ * gam[j] + bet[j]; o8_[64 * j] = (unsigned long long)pk2(V[j].x, V[j].y) | ((unsigned long long)pk2(V[j].z, V[j].w) << 32); } \
    } while (0)
#define ROUTE_DOT4(OUT, V, wrow0) do { \
        _Pragma("unroll") for (int o = 0; o < 4; ++o) { float p = 0.f; \
            f32x2 p2_ = {0.f, 0.f}; \
            _Pragma("unroll") for (int j = 0; j < 4; ++j) { const f32x4 w = *(const LAS f32x4*)(WL + ((wrow0) + o) * D + F.lane * 4 + 256 * j); \
                p2_ = __builtin_elementwise_fma((f32x2){V[j].x, V[j].y}, (f32x2){w.x, w.y}, p2_); p2_ = __builtin_elementwise_fma((f32x2){V[j].z, V[j].w}, (f32x2){w.z, w.w}, p2_); } \
            p = p2_.x + p2_.y; ps[o * 68 + F.lane] = p; } \
        float tot = 0.f; \
        if (F.lane < 4) { _Pragma("unroll") for (int k = 0; k < 16; ++k) { const f32x4 x = *(const LAS f32x4*)(ps + F.lane * 68 + 4 * k); tot += (x.x + x.y) + (x.z + x.w); } } \
        _Pragma("unroll") for (int o = 0; o < 4; ++o) OUT[o] = __builtin_bit_cast(float, __builtin_amdgcn_readlane(__builtin_bit_cast(int, tot), o)); } while (0)
#define LNR_B(r_, V) do { \
        float lgq[4], el[4]; \
        ROUTE_DOT4(lgq, V, 0); \
        float g0 = lgq[0] + bgr[0]; int gi = 0; \
        _Pragma("unroll") for (int o = 1; o < 4; ++o) { const float x = lgq[o] + bgr[o]; if (x > g0) { g0 = x; gi = o; } } \
        float gs = 0.f; \
        _Pragma("unroll") for (int o = 0; o < 4; ++o) gs += __expf(lgq[o] + bgr[o] - g0); \
        const float gwt = 1.0f / gs;                              \
        const int giu = __builtin_amdgcn_readfirstlane(gi); \
        ROUTE_DOT4(el, V, 4 + 4 * giu); \
        _Pragma("unroll") for (int j = 0; j < 4; ++j) { float bb = bex[j]; \
            _Pragma("unroll") for (int g = 1; g < 4; ++g) bb = (gi == g) ? bex[4 * g + j] : bb; \
            el[j] += bb; } \
        float m1 = el[0]; int i1 = 0; \
        _Pragma("unroll") for (int j = 1; j < 4; ++j) if (el[j] > m1) { m1 = el[j]; i1 = j; } \
        float m2 = -INFINITY; int i2 = 0; \
        _Pragma("unroll") for (int j = 0; j < 4; ++j) if (j != i1 && el[j] > m2) { m2 = el[j]; i2 = j; } \
        const float p2 = __expf(m2 - m1);                          \
        const float w1 = gwt / (1.0f + p2), w2 = gwt * p2 / (1.0f + p2); \
        const int e0 = __builtin_amdgcn_readfirstlane(gi * 4 + i1), e1 = __builtin_amdgcn_readfirstlane(gi * 4 + i2); \
        const int l0 = __builtin_amdgcn_readlane(cnt, e0); cnt += (F.lane == e0) ? 1 : 0; \
        const int l1 = __builtin_amdgcn_readlane(cnt, e1); cnt += (F.lane == e1) ? 1 : 0; \
        if (F.lane == 0) { route_e[(r_)] = (unsigned)e0 | ((unsigned)e1 << 4) | ((unsigned)l0 << 8) | ((unsigned)l1 << 16); route_w[(r_)] = (f32x2){w1, w2}; } \
    } while (0)
    if (gw < nrows) {
        f32x4 vp[4]; int rp = gw;
        LNR_A(gw, vp);
        for (int r = gw + NGW; r < nrows; r += NGW) {
            f32x4 vn[4];
            LNR_A(r, vn);
            LNR_B(rp, vp);
#pragma unroll
            for (int j = 0; j < 4; ++j) vp[j] = vn[j];
            rp = r;
        }
        LNR_B(rp, vp);
    }
#undef LNR_A
#undef LNR_B
#undef ROUTE_DOT4
    if (F.lane < 16) wcnt[F.wave * 16 + F.lane] = cnt;
    __syncthreads();
    if (F.tid < 16) {
        int* WB = (int*)(F.ws + WS_WB) + (size_t)blockIdx.x * 128; int* BC = (int*)(F.ws + WS_BCNT) + (size_t)blockIdx.x * 16;
        int run = 0;
#pragma unroll
        for (int w = 0; w < 8; ++w) { WB[w * 16 + F.tid] = run; run += wcnt[w * 16 + F.tid]; }
        BC[F.tid] = run;
    }
    __syncthreads();
}

__device__ __forceinline__ void dispatch_phase(Frame& F, int nrows) {
    int* rowidx = (int*)(F.ctl + CW_ROWIDX);
    const unsigned* route_e = (const unsigned*)(F.ws + WS_ROUTE_E); v2u* route_p = (v2u*)(F.ws + WS_ROUTE_P);
    const int* BC = (const int*)(F.ws + WS_BCNT); const int* WB = (const int*)(F.ws + WS_WB) + (size_t)blockIdx.x * 128;
    int* TS = (int*)(F.ws + WS_TSTART);
    LAS int* bc = (LAS int*)(F.lds + RING_OFF);
    LAS int* tot = (LAS int*)(F.lds + RING_OFF + 16384); LAS int* bpre = tot + 16; LAS int* base = tot + 32;
    for (int idx = F.tid; idx < F.G * 16; idx += 512) bc[idx] = BC[idx];
    __syncthreads();
    if (F.tid < 16) { int s = 0, pre = 0; for (int b = 0; b < F.G; ++b) { if (b == (int)blockIdx.x) pre = s; s += bc[b * 16 + F.tid]; } tot[F.tid] = s; bpre[F.tid] = pre; }
    __syncthreads();
    if (F.tid == 0) { int t = 0; for (int e = 0; e < 16; ++e) { if (blockIdx.x == 0) TS[e] = t; base[e] = t * 256 + bpre[e]; t += (tot[e] + 255) >> 8; } if (blockIdx.x == 0) TS[16] = t; }
    __syncthreads();
    const int mybase = (F.lane < 16) ? base[F.lane] + WB[F.wave * 16 + F.lane] : 0;
    const int gw = blockIdx.x * NWAVES + F.wave, NGW = F.G * NWAVES;
    for (int r = gw; r < nrows; r += NGW) {
        const unsigned re = __builtin_amdgcn_readfirstlane(route_e[r]);
        const int e0 = re & 15, e1 = (re >> 4) & 15, l0 = (re >> 8) & 255, l1 = (re >> 16) & 255;
        const int pos0 = __builtin_amdgcn_readlane(mybase, e0) + l0, pos1 = __builtin_amdgcn_readlane(mybase, e1) + l1;
        if (F.lane == 0) { route_p[r] = (v2u){(unsigned)pos0, (unsigned)pos1}; rowidx[pos0] = r; rowidx[pos1] = r; }
    }
    __syncthreads();
}

template <int LAYER, bool FINAL> __device__ __forceinline__ void ln_combine_phase(Frame& F, int nrows) {
    const bf16* Ys = (const bf16*)(F.ws + WS_R3); bf16* A = (bf16*)(F.ws + WS_A);
    const f32x2* route_w = (const f32x2*)(F.ws + WS_ROUTE_W); const v2u* route_p = (const v2u*)(F.ws + WS_ROUTE_P);
    const float* gp = F.in[19] + (size_t)(LAYER * 2 + 1) * D; const float* bp = F.in[20] + (size_t)(LAYER * 2 + 1) * D;
    f32x4 gam[4], bet[4];
#pragma unroll
    for (int j = 0; j < 4; ++j) { gam[j] = *(const f32x4*)(gp + F.lane * 4 + 256 * j); bet[j] = *(const f32x4*)(bp + F.lane * 4 + 256 * j); }
    const int gw = blockIdx.x * NWAVES + F.wave, NGW = F.G * NWAVES;
    for (int r = gw; r < nrows; r += NGW) {
        const f32x2 cw = route_w[r]; const v2u ps = route_p[r];
        const GAS v2u* hb = (const GAS v2u*)(A + (size_t)r * D) + F.lane;
        GAS f32x4* hr = (GAS f32x4*)(F.out + (size_t)(FINAL ? r : 0) * D) + F.lane;
        const GAS v2u* y0 = (const GAS v2u*)(Ys + (size_t)ps.x * D) + F.lane; const GAS v2u* y1 = (const GAS v2u*)(Ys + (size_t)ps.y * D) + F.lane;
        f32x4 v[4]; float s = 0.f;
#pragma unroll
        for (int j = 0; j < 4; ++j) {
            const v2u hq = hb[64 * j]; const f32x4 h = {bflo(hq.x), bfhi(hq.x), bflo(hq.y), bfhi(hq.y)}; const v2u a = y0[64 * j], b = y1[64 * j];
            const f32x4 fa = {bflo(a.x), bfhi(a.x), bflo(a.y), bfhi(a.y)}, fb = {bflo(b.x), bfhi(b.x), bflo(b.y), bfhi(b.y)};
            v[j] = ALPHA * h + (cw.x * fa + cw.y * fb);
            s += (v[j].x + v[j].y) + (v[j].z + v[j].w); }
        const float mean = wave_sum(s) * (1.f / D); float s2 = 0.f;
#pragma unroll
        for (int j = 0; j < 4; ++j) { v[j] = v[j] - mean; s2 += (v[j].x * v[j].x + v[j].y * v[j].y) + (v[j].z * v[j].z + v[j].w * v[j].w); }
        const float rstd = __builtin_amdgcn_rsqf(wave_sum(s2) * (1.f / D) + LN_EPS);
        GAS unsigned long long* o8 = (GAS unsigned long long*)(A + (size_t)r * D) + F.lane;
#pragma unroll
        for (int j = 0; j < 4; ++j) { v[j] = v[j] * rstd * gam[j] + bet[j]; if (FINAL) hr[64 * j] = v[j];
            if (!FINAL) o8[64 * j] = (unsigned long long)pk2(v[j].x, v[j].y) | ((unsigned long long)pk2(v[j].z, v[j].w) << 32); }
    }
}

namespace att {
constexpr int KOFF = 0, VOFF = 49152, XOFF = 98304, SLOT = 16384;
typedef __bf16 bf16x2_t __attribute__((ext_vector_type(2)));
__device__ __forceinline__ unsigned cvtpk_s(float lo, float hi) { f32x2 v = {lo, hi}; bf16x2_t b = __builtin_convertvector(v, bf16x2_t); return __builtin_bit_cast(unsigned, b); }
__device__ __forceinline__ bf16x8 packp(const f32x16& p, int s) {
    v4u w; w.x = cvtpk_s(p[8 * s + 0], p[8 * s + 1]); w.y = cvtpk_s(p[8 * s + 2], p[8 * s + 3]); w.z = cvtpk_s(p[8 * s + 4], p[8 * s + 5]); w.w = cvtpk_s(p[8 * s + 6], p[8 * s + 7]);
    return __builtin_bit_cast(bf16x8, w);
}
__device__ __forceinline__ void glds16(const void* gsrc, unsigned lds_dst) { unsigned keep;
    asm volatile("s_mov_b32 %0, m0\n\ts_mov_b32 m0, %2\n\ts_nop 0\n\tglobal_load_lds_dwordx4 %1, off\n\ts_mov_b32 m0, %0" : "=&s"(keep) : "v"(gsrc), "s"(lds_dst) : "memory"); }
#define ATT_BAR_V(N) asm volatile("s_waitcnt vmcnt(" #N ") lgkmcnt(0)\n\ts_barrier" ::: "memory")
#define ATT_BAR() asm volatile("s_waitcnt lgkmcnt(0)\n\ts_barrier" ::: "memory")
typedef short v4i16_t __attribute__((ext_vector_type(4)));
__device__ __forceinline__ s16x4 vtr(LAS const unsigned char* p) { return __builtin_bit_cast(s16x4, __builtin_amdgcn_ds_read_tr16_b64_v4i16((LAS v4i16_t*)p)); }

__device__ __forceinline__ void qk_tile(f32x16& s0, f32x16& s1, LAS const unsigned char* kb, int hi, int kx, const bf16x8 (&qf)[4], const f32x16& negv) {
#pragma unroll
    for (int d0 = 0; d0 < 4; ++d0) {
        const int co = ((2 * d0 + hi) ^ kx) << 4;
        const bf16x8 kf0 = *(LAS const bf16x8*)(kb + co), kf1 = *(LAS const bf16x8*)(kb + 4096 + co);
        s0 = __builtin_amdgcn_mfma_f32_32x32x16_bf16(kf0, qf[d0], d0 == 0 ? negv : s0, 0, 0, 0);
        s1 = __builtin_amdgcn_mfma_f32_32x32x16_bf16(kf1, qf[d0], d0 == 0 ? negv : s1, 0, 0, 0);
    }
}
template <bool FIRST> __device__ __forceinline__ float softmax_pack(f32x16& s0, f32x16& s1, bf16x8 (&P)[4]) {
#pragma unroll
    for (int r = 0; r < 16; ++r) { s0[r] = FIRST ? 0.f : fast_exp2(s0[r]); s1[r] = (FIRST && r < 8) ? 0.f : fast_exp2(s1[r]); }
    float sa = 0.f, sb = 0.f;
#pragma unroll
    for (int r = 0; r < 16; ++r) { sa += s0[r]; asm volatile("" : "+v"(sa)); sb += s1[r]; asm volatile("" : "+v"(sb)); }
    P[0] = packp(s0, 0); P[1] = packp(s0, 1); P[2] = packp(s1, 0); P[3] = packp(s1, 1);
    return sa + sb;
}
__device__ __forceinline__ void pv_tile(f32x16 (&Oa)[4], LAS const unsigned char* va0, LAS const unsigned char* va1, const bf16x8 (&P)[4]) {
#pragma unroll
    for (int dblk = 0; dblk < 4; ++dblk)
#pragma unroll
        for (int hs = 0; hs < 4; ++hs) {
            const s16x4 a0 = vtr(va0 + 4096 * hs + 512 * dblk);
            const s16x4 a1 = vtr(va1 + 4096 * hs + 2048 + 512 * dblk);
            const bf16x8 vf = {a0[0], a0[1], a0[2], a0[3], a1[0], a1[1], a1[2], a1[3]};
            Oa[dblk] = __builtin_amdgcn_mfma_f32_32x32x16_bf16(vf, P[hs], Oa[dblk], 0, 0, 0);
        }
}

__device__ __forceinline__ void mseg(f32x16& s0, f32x16& s1, f32x16 (&Oa)[4], LAS const unsigned char* kb, int hi, int kx, const bf16x8 (&qf)[4], const f32x16& negv,
                                     LAS const unsigned char* va0, LAS const unsigned char* va1, const bf16x8 (&P)[4]) {
    bf16x8 kf0[4], kf1[4];
#pragma unroll
    for (int d0 = 0; d0 < 4; ++d0) { const int co = ((2 * d0 + hi) ^ kx) << 4; kf0[d0] = *(LAS const bf16x8*)(kb + co); kf1[d0] = *(LAS const bf16x8*)(kb + 4096 + co); }
    s16x4 ga0[4], ga1[4], gb0[4], gb1[4];
#define VGRP(A0, A1, dblk) do { _Pragma("unroll") for (int hs = 0; hs < 4; ++hs) { A0[hs] = vtr(va0 + 4096 * hs + 512 * (dblk)); A1[hs] = vtr(va1 + 4096 * hs + 2048 + 512 * (dblk)); } } while (0)
#define PVGRP(A0, A1, dblk) do { _Pragma("unroll") for (int hs = 0; hs < 4; ++hs) { const bf16x8 vf = {A0[hs][0], A0[hs][1], A0[hs][2], A0[hs][3], A1[hs][0], A1[hs][1], A1[hs][2], A1[hs][3]}; \
        Oa[dblk] = __builtin_amdgcn_mfma_f32_32x32x16_bf16(vf, P[hs], Oa[dblk], 0, 0, 0); } } while (0)
    VGRP(ga0, ga1, 0);
    __builtin_amdgcn_sched_barrier(0);
#pragma unroll
    for (int d0 = 0; d0 < 4; ++d0) {
        s0 = __builtin_amdgcn_mfma_f32_32x32x16_bf16(kf0[d0], qf[d0], d0 == 0 ? negv : s0, 0, 0, 0);
        s1 = __builtin_amdgcn_mfma_f32_32x32x16_bf16(kf1[d0], qf[d0], d0 == 0 ? negv : s1, 0, 0, 0);
    }
    __builtin_amdgcn_sched_barrier(0);
    VGRP(gb0, gb1, 1); __builtin_amdgcn_sched_barrier(0); PVGRP(ga0, ga1, 0); __builtin_amdgcn_sched_barrier(0);
    VGRP(ga0, ga1, 2); __builtin_amdgcn_sched_barrier(0); PVGRP(gb0, gb1, 1); __builtin_amdgcn_sched_barrier(0);
    VGRP(gb0, gb1, 3); __builtin_amdgcn_sched_barrier(0); PVGRP(ga0, ga1, 2); __builtin_amdgcn_sched_barrier(0);
    PVGRP(gb0, gb1, 3);
#undef VGRP
#undef PVGRP
}

template <int VAR> __device__ __forceinline__ void attn_unit(Frame& F, int b, int h, int t, float lam) {
    const bf16* Q = (const bf16*)(F.ws + WS_R3); const bf16* Kb = (const bf16*)(F.ws + WS_K); const bf16* Vb = (const bf16*)(F.ws + WS_R1);
    bf16* O = (bf16*)(F.ws + (VAR ? WS_A : WS_R2));
    const unsigned* kmax = (const unsigned*)(F.ctl + CW_KMAX);
    LAS unsigned char* lds = F.lds + RING_OFF;
    int lane = F.lane; asm volatile("" : "+v"(lane));
    const int w = F.wave, r32 = lane & 31, hi = lane >> 5;
    const int g = w & 3, c = w >> 2;
    const int qrow = b * SEQ + 128 * t + 32 * g + r32;
    const int NT = 2 * t + 3, jmax = 2 * t + 1 + (g >> 1);
    const bf16* kg; const bf16* vg0; const bf16* vg1;
    {
        const int row = 8 * w + (lane >> 3), sc = (lane & 7) ^ ((row >> 1) & 7);
        kg = Kb + ((size_t)b * LP + row) * D + h * 128 + sc * 8;
        const int rr = (lane >> 2) & 7, x = lane & 3, sub = lane >> 5;
        { const int q = w, rg = q >> 1, cp = q & 1, rowv = 8 * rg + rr, ch = 4 * (2 * cp + sub) + (x ^ ((rowv >> 2) & 3)); vg0 = Vb + ((size_t)b * LP + rowv) * D + h * 128 + ch * 8; }
        { const int q = w + 8, rg = q >> 1, cp = q & 1, rowv = 8 * rg + rr, ch = 4 * (2 * cp + sub) + (x ^ ((rowv >> 2) & 3)); vg1 = Vb + ((size_t)b * LP + rowv) * D + h * 128 + ch * 8; }
    }
    const unsigned ldsb = (unsigned)(size_t)lds;
#define DMA_K(j, slot) do { glds16(kg + (size_t)(j) * 64 * D, (unsigned)__builtin_amdgcn_readfirstlane(ldsb + KOFF + (slot) + w * 1024)); \
                            glds16(kg + (size_t)(j) * 64 * D + 64, (unsigned)__builtin_amdgcn_readfirstlane(ldsb + KOFF + (slot) + 8192 + w * 1024)); } while (0)
#define DMA_V(j, slot) do { glds16(vg0 + (size_t)(j) * 64 * D, (unsigned)__builtin_amdgcn_readfirstlane(ldsb + VOFF + (slot) + w * 1024)); \
                            glds16(vg1 + (size_t)(j) * 64 * D, (unsigned)__builtin_amdgcn_readfirstlane(ldsb + VOFF + (slot) + 8192 + w * 1024)); } while (0)
    DMA_K(0, 0); DMA_V(0, 0); DMA_K(1, SLOT); DMA_V(1, SLOT); DMA_K(2, 2 * SLOT);
    bf16x8 qf[4]; float negm;
    {
        float n2 = 0.f;
#pragma unroll
        for (int d0 = 0; d0 < 4; ++d0) {
            const v4u q = *(const v4u*)(Q + (size_t)qrow * D + h * 128 + c * 64 + d0 * 16 + hi * 8);
            qf[d0] = __builtin_bit_cast(bf16x8, q);
            const float x0 = bflo(q.x), x1 = bfhi(q.x), x2 = bflo(q.y), x3 = bfhi(q.y), x4 = bflo(q.z), x5 = bfhi(q.z), x6 = bflo(q.w), x7 = bfhi(q.w);
            n2 += (x0 * x0 + x1 * x1) + (x2 * x2 + x3 * x3) + (x4 * x4 + x5 * x5) + (x6 * x6 + x7 * x7); }
        n2 += __shfl_xor(n2, 32);
        const float ka = __builtin_bit_cast(float, kmax[(b * 16 + h * 2 + c) * 2 + 0]), kb2 = __builtin_bit_cast(float, kmax[(b * 16 + h * 2 + c) * 2 + 1]);
        negm = -(sqrtf(n2) * sqrtf(ka + kb2) * 1.01f + 0.01f);
    }
    f32x16 Oa[4];
#pragma unroll
    for (int i = 0; i < 4; ++i) Oa[i] = (f32x16){};
    float lsum = 0.f;
    f32x16 negv;
#pragma unroll
    for (int r = 0; r < 16; ++r) negv[r] = negm;
    asm volatile("" : "+v"(negv));
    const int kx = (r32 >> 1) & 7;
    const int pq = (lane & 15) >> 2, pp = lane & 3, blk = (lane >> 4) & 1;
    const int vb0 = 64 * (4 * hi + pq) + 16 * ((2 * blk + (pp >> 1)) ^ (hi + 0)) + 8 * (pp & 1);
    const int vb1 = 64 * (4 * hi + pq) + 16 * ((2 * blk + (pp >> 1)) ^ (hi + 2)) + 8 * (pp & 1);
    LAS const unsigned char* kbase = lds + KOFF + c * 8192 + r32 * 128;
    LAS const unsigned char* vbase0 = lds + VOFF + vb0;
    LAS const unsigned char* vbase1 = lds + VOFF + vb1;
    bf16x8 P[4];
    f32x16 s0, s1;
    ATT_BAR_V(0);
    qk_tile(s0, s1, kbase, hi, kx, qf, negv);
    lsum += softmax_pack<true>(s0, s1, P);
    if (c == 1) ATT_BAR();
    int sk = 0, sk1 = SLOT, sv2 = 2 * SLOT;
#pragma unroll 1
    for (int s = 0; s < NT; ++s) {
        if (s <= jmax) {

            mseg(s0, s1, Oa, kbase + sk1, hi, kx, qf, negv, vbase0 + sk, vbase1 + sk, P);

        }
        if (c == 1) ATT_BAR_V(0); else ATT_BAR();
        if (!(VAR & 2)) { if (s + 3 < NT) DMA_K(s + 3, sk); if (s + 2 < NT) DMA_V(s + 2, sv2); }
        if (s < jmax) lsum += softmax_pack<false>(s0, s1, P);
        if (c == 0) { if (s + 3 < NT) ATT_BAR_V(4); else ATT_BAR_V(0); } else ATT_BAR();
        { const int tmp = sk; sk = sk1; sk1 = sv2; sv2 = tmp; }
    }
    if (c == 0) ATT_BAR();
#undef DMA_K
#undef DMA_V
    lsum += __shfl_xor(lsum, 32);
    LAS float* X = (LAS float*)(lds + XOFF) + g * 2048 + lane;
    const float sc = (c == 1) ? lam / lsum : 1.0f / lsum;
    float ss = 0.f;
#pragma unroll
    for (int p = 0; p < 2; ++p) {
        if (c == 1) {
#pragma unroll
            for (int d2 = 0; d2 < 2; ++d2)
#pragma unroll
                for (int r = 0; r < 16; ++r) X[(d2 * 16 + r) * 64] = Oa[2 * p + d2][r] * sc;
        }
        __syncthreads();
        if (c == 0) {
#pragma unroll
            for (int d2 = 0; d2 < 2; ++d2)
#pragma unroll
                for (int r = 0; r < 16; ++r) { const float o = Oa[2 * p + d2][r] * sc - X[(d2 * 16 + r) * 64]; Oa[2 * p + d2][r] = o; ss += o * o; }
        }
        __syncthreads();
    }
    if (c == 0) {
        ss += __shfl_xor(ss, 32);
        const float rn = (1.0f / sqrtf(ss * (1.0f / 128.0f) + LN_EPS)) * (1.0f - LAM_INIT);
        const float* sg = F.in[17];
        bf16* orow = O + (size_t)qrow * D + h * 128;
#pragma unroll
        for (int dblk = 0; dblk < 4; ++dblk)
#pragma unroll
            for (int rq = 0; rq < 4; ++rq) {
                const int d0 = 32 * dblk + 8 * rq + 4 * hi;
                const f32x4 gg = *(const f32x4*)(sg + d0);
                v2u wv; wv.x = pk2(Oa[dblk][4 * rq + 0] * rn * gg.x, Oa[dblk][4 * rq + 1] * rn * gg.y); wv.y = pk2(Oa[dblk][4 * rq + 2] * rn * gg.z, Oa[dblk][4 * rq + 3] * rn * gg.w);
                *(v2u*)(orow + d0) = wv;
            }
    }
}
template <int VAR> __device__ __forceinline__ void attn_phase(Frame& F) {
    const float d1 = wave_sum(F.in[13][F.lane] * F.in[14][F.lane]), d2 = wave_sum(F.in[15][F.lane] * F.in[16][F.lane]);
    const float lam = __expf(d1) - __expf(d2) + LAM_INIT;
    for (int pi = F.vcu; pi < 1024; pi += F.G) {
        const int bh = pi >> 6, tp = pi & 63;
#pragma unroll 1
        for (int k = 0; k < 2; ++k) attn_unit<VAR>(F, bh >> 3, bh & 7, k ? 127 - tp : tp, lam);
    }
}
}

constexpr int N_PHASES = 17;
struct Args { const float* in[28]; float* out; unsigned char* ws; int ph_lo, ph_hi, li, pad; };
__global__ void __launch_bounds__(NWAVES * 64, 2) mk_fwd(Args args) {
    extern __shared__ __attribute__((aligned(16))) unsigned char lds[];
    Frame F;
    F.lds = (LAS unsigned char*)lds;
    F.MISC = (volatile LAS unsigned*)(F.lds + MISC_OFF);
    F.tid = threadIdx.x; F.lane = F.tid & 63; F.wave = __builtin_amdgcn_readfirstlane(F.tid >> 6);
    F.G = gridDim.x; { const int bx = blockIdx.x; F.vcu = (F.G % 8 == 0) ? (bx % 8) * (F.G / 8) + bx / 8 : bx; }
    F.ws = args.ws; F.ctl = (gu32*)(args.ws + WS_CTL); F.out = args.out;
#pragma unroll
    for (int i = 0; i < 28; ++i) F.in[i] = args.in[i];
    for (int u = F.tid; u < (LDS_BYTES - LDSCTL_OFF) / 4; u += NWAVES * 64) ((LAS unsigned*)(F.lds + LDSCTL_OFF))[u] = 0u;
    __syncthreads();
    const bool one_phase = (args.ph_hi - args.ph_lo) == 1;
    XcdBarrier bar; bar.bar = (unsigned*)(F.ctl + CW_BAR) + args.li * XCD_BAR_WORDS; bar.x = 0; bar.st = nullptr;
    if (!one_phase) bar = xcd_barrier_post((unsigned*)(F.ctl + CW_BAR) + args.li * XCD_BAR_WORDS, F.MISC + 8);
    const int lo = args.ph_lo, hi = args.ph_hi;
#ifndef PHMASK
#define PHMASK 0x1ffff
#endif
#define IN(k) ((((PHMASK) >> (k)) & 1) && lo <= (k) && (k) < hi)
#define SEAM(k) do { if (IN(k) && IN((k) + 1)) xcd_barrier(bar); } while (0)
    unsigned char* ws = args.ws;
    bf16* A = (bf16*)(ws + WS_A);
    const int* TS = (const int*)(ws + WS_TSTART);

    if (IN(0)) { p0_prologue(F); SEAM(0); }
    if (IN(1)) {
        DenseOrder S; S.init(A, ws + WS_WPW1, D, NREAL / 256, 8, F.G, (int)blockIdx.x);
        EpiGLU E{(bf16*)(ws + WS_R2), F.in[3]};
        pg8::gemm_phase<EpiGLU, DenseOrder, true, true>(F.lds + RING_OFF, D, S, E);
        mini_glu(F);
        SEAM(1);
    }
    if (IN(2)) { conv_phase(F); SEAM(2); }
    if (IN(3)) {
        DenseOrder S; S.init(ws + WS_R3, ws + WS_WPW2, D, NREAL / 256, 4, F.G, (int)blockIdx.x);
        EpiBf16 E{(bf16*)(ws + WS_R1), F.in[9]};
        pg8::gemm_phase<EpiBf16, DenseOrder, true, true>(F.lds + RING_OFF, D, S, E);
        mini_pw2(F);
        SEAM(3);
    }
    if (IN(4)) { ln_route_phase<0>(F, NTOK0); SEAM(4); }
    if (IN(5)) { dispatch_phase(F, NTOK0); SEAM(5); }
    if (IN(6)) {
        MoeOrder S; S.init(A, ws + WS_W13, D, 4, (size_t)D * D * 2, TS, F.G, (int)blockIdx.x); S.gather = true;
        LAS int* gtab = (LAS int*)(F.lds + GTAB_OFF);
        { const int* rowidx = (const int*)(F.ctl + CW_ROWIDX); pg8::Unit gu;
#pragma unroll
          for (int i = 0; i < 6; ++i) if (S.next(i, gu) && F.tid < 256) gtab[i * 256 + F.tid] = rowidx[gu.pm * 256 + F.tid];
          __syncthreads(); }
        EpiSwiGLU E{(bf16*)(ws + WS_R2)};
        pg8::gemm_phase<EpiSwiGLU, MoeOrder, true, true, true>(F.lds + RING_OFF, D, S, E, gtab);
        {
            const int nlate = S.d.nwg - 4 * F.G;
            if (nlate <= 0 || nlate >= F.G) moe_weights_convert(F, 1, blockIdx.x * NWAVES + F.wave, F.G * NWAVES);
            else if ((int)blockIdx.x >= nlate) moe_weights_convert(F, 1, ((int)blockIdx.x - nlate) * NWAVES + F.wave, (F.G - nlate) * NWAVES);
        }
        SEAM(6);
    }
    if (IN(7)) {
        MoeOrder S; S.init(ws + WS_R2, ws + WS_W2T, DE, 4, (size_t)D * DE * 2, TS, F.G, (int)blockIdx.x);
        EpiBf16 E{(bf16*)(ws + WS_R3), nullptr};
        pg8::gemm_phase<EpiBf16, MoeOrder, true, true>(F.lds + RING_OFF, DE, S, E);
        SEAM(7);
    }
    if (IN(8)) {
        ln_combine_phase<0, false>(F, NTOK0);
        SEAM(8);
    }
    if (IN(9)) {
        if (blockIdx.x == 0) {
            for (int i = F.tid; i < 2 * 2 * 48 * 128; i += 512) { const int which = i / (2 * 48 * 128), rem = i % (2 * 48 * 128), bb = rem / (48 * 128), o = rem % (48 * 128);
                v4u* p = (v4u*)((which ? ws + WS_R1 : ws + WS_K) + (size_t)bb * LP * D * 2) + o; *p = (v4u){0u, 0u, 0u, 0u}; }
        }
        DenseOrder S; S.init(A, ws + WS_WQKV, D, NREAL / 256, 12, F.G, (int)blockIdx.x);
        EpiQKV E{(bf16*)(ws + WS_R3), (bf16*)(ws + WS_K), (bf16*)(ws + WS_R1), (const f32x4*)(ws + WS_ROPE), (unsigned*)(F.ctl + CW_KMAX)};
        pg8::gemm_phase<EpiQKV, DenseOrder, true, true>(F.lds + RING_OFF, D, S, E);
        mini_kv(F);
        SEAM(9);
    }
#ifndef MK_ATT_PROBE
#define MK_ATT_PROBE 0
#endif
    if (IN(10)) { att::attn_phase<0>(F); if (MK_ATT_PROBE) { __syncthreads(); att::attn_phase<MK_ATT_PROBE>(F); } SEAM(10); }
    if (IN(11)) {
        DenseOrder S; S.init(ws + WS_R2, ws + WS_WO, D, NREAL / 256, 4, F.G, (int)blockIdx.x);
        EpiBf16 E{(bf16*)(ws + WS_R1), nullptr};
        pg8::gemm_phase<EpiBf16, DenseOrder, true, true>(F.lds + RING_OFF, D, S, E);
        SEAM(11);
    }
    if (IN(12)) { ln_route_phase<1>(F, NREAL); SEAM(12); }
    if (IN(13)) { dispatch_phase(F, NREAL); SEAM(13); }
    if (IN(14)) {
        MoeOrder S; S.init(A, ws + WS_W13B, D, 4, (size_t)D * D * 2, TS, F.G, (int)blockIdx.x); S.gather = true;
        LAS int* gtab = (LAS int*)(F.lds + GTAB_OFF);
        { const int* rowidx = (const int*)(F.ctl + CW_ROWIDX); pg8::Unit gu;
#pragma unroll
          for (int i = 0; i < 6; ++i) if (S.next(i, gu) && F.tid < 256) gtab[i * 256 + F.tid] = rowidx[gu.pm * 256 + F.tid];
          __syncthreads(); }
        EpiSwiGLU E{(bf16*)(ws + WS_R2)};
        pg8::gemm_phase<EpiSwiGLU, MoeOrder, true, true, true>(F.lds + RING_OFF, D, S, E, gtab);
        SEAM(14);
    }
    if (IN(15)) {
        MoeOrder S; S.init(ws + WS_R2, ws + WS_W2TB, DE, 4, (size_t)D * DE * 2, TS, F.G, (int)blockIdx.x);
        EpiBf16 E{(bf16*)(ws + WS_R3), nullptr};
        pg8::gemm_phase<EpiBf16, MoeOrder, true, true>(F.lds + RING_OFF, DE, S, E);
        SEAM(15);
    }
    if (IN(16)) { ln_combine_phase<1, true>(F, NREAL); }
#ifdef MK_DUMP
    if (lo == 17) {
        const int gw = blockIdx.x * NWAVES + F.wave, NGW = F.G * NWAVES;
        const bf16* Qd = (const bf16*)(ws + WS_R3); const bf16* Kd = (const bf16*)(ws + WS_K); const bf16* Vd = (const bf16*)(ws + WS_R1); const bf16* Od = (const bf16*)(ws + WS_R2);
        for (int r = gw; r < NREAL; r += NGW) {
            const int b = r >> 14, sq = r & (SEQ - 1);
            for (int j = 0; j < 16; ++j) { const int c = F.lane + 64 * j;
                float v = 0.f;
                if (MK_DUMP == 1) v = bflo(Qd[(size_t)r * D + c]) + bflo(Kd[((size_t)b * LP + 64 + sq) * D + c]) + bflo(Vd[((size_t)b * LP + 64 + sq) * D + c]);
                if (MK_DUMP == 2) v = bflo(Od[(size_t)r * D + c]);
                if (MK_DUMP == 4) { v = 0.f;
                    if (r < 64) v = bflo(Kd[(size_t)r * D + c]); else if (r < 128) v = bflo(Vd[(size_t)(r - 64) * D + c]);
                    else if (r < 192) v = bflo(Kd[((size_t)LP + r - 128) * D + c]); else if (r < 256) v = bflo(Vd[((size_t)LP + r - 192) * D + c]);
                    else if (r == 256 && c < 64) v = __builtin_bit_cast(float, ((const unsigned*)(F.ctl + CW_KMAX))[c]);
                    if (!(fabsf(v) < 1e30f)) v = 100.0f; }
                if (MK_DUMP == 3) { v = bflo(Od[(size_t)r * D + c]); if (!(fabsf(v) < 1e30f)) v = 100.0f; }
                F.out[(size_t)r * D + c] = v; }
        }
    }
#endif
#undef IN
#undef SEAM
}

extern "C" void kernel_launch(void* const* d_in, const int* in_sizes, int n_in, void* d_out, int out_size, void* d_ws, size_t ws_size, hipStream_t stream) {
    static int grid = 0;
    if (grid == 0) {
        if (n_in != 28 || out_size != NREAL * D || ws_size < WS_END) { fprintf(stderr, "kernel_launch: unexpected shapes (n_in %d, out %d, ws %zu); nothing launched\n", n_in, out_size, ws_size); grid = -1; return; }
        int dev = 0, cus = 0, per_cu = 0;
        if (hipGetDevice(&dev) != hipSuccess || hipDeviceGetAttribute(&cus, hipDeviceAttributeMultiprocessorCount, dev) != hipSuccess) { grid = -1; return; }
        if (hipFuncSetAttribute((const void*)mk_fwd, hipFuncAttributeMaxDynamicSharedMemorySize, LDS_BYTES) != hipSuccess) { fprintf(stderr, "kernel_launch: hipFuncSetAttribute failed\n"); grid = -1; return; }
        if (hipOccupancyMaxActiveBlocksPerMultiprocessor(&per_cu, (const void*)mk_fwd, NWAVES * 64, LDS_BYTES) != hipSuccess || per_cu < 1) { fprintf(stderr, "kernel_launch: occupancy query says %d\n", per_cu); }
        (void)hipGetLastError();
        grid = cus > 256 ? 256 : cus;
    }
    if (grid < 0) return;
    if (hipMemsetAsync((char*)d_ws + WS_CTL, 0, CTL_ZERO_BYTES, stream) != hipSuccess) return;
    Args a{};
    for (int i = 0; i < 28; ++i) a.in[i] = (const float*)d_in[i];
    a.out = (float*)d_out; a.ws = (unsigned char*)d_ws;
#ifdef MK_PROBE_SCHED
    { static const int sched[] = MK_PROBE_SCHED;
      for (unsigned k = 0; k < sizeof(sched) / sizeof(sched[0]); ++k) { a.ph_lo = sched[k]; a.ph_hi = sched[k] + 1; a.li = 0; a.pad = 0; hipLaunchKernelGGL(mk_fwd, dim3(grid), dim3(NWAVES * 64), LDS_BYTES, stream, a); }
      return; }
#endif
    constexpr int NL = MK_N_LAUNCHES;
#ifndef MK_STOP
#define MK_STOP N_PHASES
#endif
    for (int li = 0; li < NL && li < MK_STOP; ++li) {
        a.ph_lo = (NL == 1) ? 0 : li; a.ph_hi = (NL == 1) ? N_PHASES : li + 1; a.li = (NL == 1) ? 0 : 0; a.pad = 0;
        hipLaunchKernelGGL(mk_fwd, dim3(grid), dim3(NWAVES * 64), LDS_BYTES, stream, a);
    }
#ifdef MK_DUMP
    a.ph_lo = 17; a.ph_hi = 18; a.li = 0; hipLaunchKernelGGL(mk_fwd, dim3(grid), dim3(NWAVES * 64), LDS_BYTES, stream, a);
#endif
}
```

```cpp
#include <hip/hip_runtime.h>
#include <cstdio>
#include <cstdint>

#ifndef MK_N_LAUNCHES
#define MK_N_LAUNCHES 1
#endif

namespace pg8 {
#define PG8_LAS __attribute__((address_space(3)))
typedef unsigned short bf16_t;
typedef short bf16x8 __attribute__((ext_vector_type(8)));
typedef float f32x4 __attribute__((ext_vector_type(4)));
typedef unsigned u32x4 __attribute__((ext_vector_type(4)));
constexpr int BM = 256, BK = 64, HALF = 128, HTB = HALF * BK * 2  , STAGE_BYTES = 8 * HTB, NXCD = 8, WGM = 8;

__host__ __device__ __forceinline__ int lds_byte(int r, int c) { const int st = (r >> 4) * 2 + (c >> 5), rr = r & 15, cc = c & 31, ob = rr * 64 + cc * 2; return st * 1024 + (ob ^ (((ob >> 9) & 1) << 5)); }
__host__ __device__ __forceinline__ void stage_rc(int b, int& R, int& C) { const int st = b / 1024, sb = b % 1024, swz = sb ^ (((sb >> 9) & 1) << 5); R = (st >> 1) * 16 + swz / 64; C = (st & 1) * 32 + (swz % 64) / 2; }
__host__ __device__ __forceinline__ int perm32(int rho) { const int n = rho >> 4, i = rho & 15; return 8 * (i >> 2) + 4 * n + (i & 3); }

struct Unit { int pm, pn; const char* A; const char* B; };

__device__ __forceinline__ unsigned cvt_pk_bf16(float lo, float hi) { unsigned r; asm volatile("v_cvt_pk_bf16_f32 %0, %1, %2" : "=v"(r) : "v"(lo), "v"(hi)); return r; }

template <class Epi, class Sched, bool ALIGN_EPI = false, bool SP2 = false, bool GATHER = false>
__device__ __forceinline__ void gemm_phase(PG8_LAS unsigned char* lds, const int K, const Sched& S, const Epi& E, const PG8_LAS int* gtab = nullptr) {
    const int tid = threadIdx.x, wid = __builtin_amdgcn_readfirstlane(tid >> 6), lane = tid & 63, wr = wid >> 2, wc = wid & 3, fr = lane & 15, fq = lane >> 4;
    const int nt = K / BK;
    unsigned voffA[2], voffB[2]; int gR[2]; unsigned gC[2];
#pragma unroll
    for (int i = 0; i < 2; ++i) { int R, C; stage_rc(tid * 16 + i * 8192, R, C); const int Rb = Epi::PERM ? ((R & ~31) + perm32(R & 31)) : R;
        voffA[i] = (unsigned)(R * K + C) * 2u; voffB[i] = (unsigned)(Rb * K + C) * 2u; gR[i] = R; gC[i] = (unsigned)C * 2u; }
    const size_t kstep = (size_t)(BK * 2);
    const size_t hstep = (size_t)HALF * K * 2;
    unsigned cvo0[2], cvo1[2], nvo0[2], nvo1[2];
#define PG8_GVO(V0, V1, ui_) do { _Pragma("unroll") for (int _i = 0; _i < 2; ++_i) { \
        if constexpr (GATHER) { V0[_i] = (unsigned)gtab[(ui_) * 256 + gR[_i]] * (unsigned)(K * 2) + gC[_i]; V1[_i] = (unsigned)gtab[(ui_) * 256 + 128 + gR[_i]] * (unsigned)(K * 2) + gC[_i]; } \
        else { V0[_i] = voffA[_i]; V1[_i] = voffA[_i] + (unsigned)hstep; } } } while (0)
    const unsigned ldsw = (unsigned)wid * 1024u;
    const int aoff = lds_byte(wr * 64 + fr, fq * 8), boff = lds_byte(wc * 32 + fr, fq * 8);
#define PG8_SA(b, h) (((b) * 2 + (h)) * HTB)
#define PG8_SB(b, h) ((4 + (b) * 2 + (h)) * HTB)
#define PG8_STAGE(bufoff, gbase, voff) do { _Pragma("unroll") for (int _i = 0; _i < 2; ++_i) \
        __builtin_amdgcn_global_load_lds((const unsigned*)((const char*)(gbase) + (voff)[_i]), (PG8_LAS unsigned*)(lds + (bufoff) + ldsw + _i * 8192), 16, 0, 0); } while (0)
#define PG8_LDA(dst, b, h) do { _Pragma("unroll") for (int m = 0; m < 4; ++m) _Pragma("unroll") for (int k = 0; k < 2; ++k) dst[m][k] = *(const PG8_LAS bf16x8*)(lds + PG8_SA(b, h) + aoff + m * 2048 + k * 1024); } while (0)
#define PG8_LDB(dst, b, h) do { _Pragma("unroll") for (int n = 0; n < 2; ++n) _Pragma("unroll") for (int k = 0; k < 2; ++k) dst[n][k] = *(const PG8_LAS bf16x8*)(lds + PG8_SB(b, h) + boff + n * 2048 + k * 1024); } while (0)
#define PG8_MMA(ai, bj, At, Bt) do { __builtin_amdgcn_s_setprio(1); _Pragma("unroll") for (int m = 0; m < 4; ++m) _Pragma("unroll") for (int n = 0; n < 2; ++n) _Pragma("unroll") for (int k = 0; k < 2; ++k) \
        acc[ai][bj][m][n] = __builtin_amdgcn_mfma_f32_16x16x32_bf16(Bt[n][k], At[m][k], acc[ai][bj][m][n], 0, 0, 0); __builtin_amdgcn_s_setprio(0); } while (0)
#define PG8_WAIT_V(n) asm volatile("s_waitcnt vmcnt(" #n ")" ::: "memory")
#define PG8_WAIT_L(n) asm volatile("s_waitcnt lgkmcnt(" #n ")" ::: "memory")
#define PG8_BAR __builtin_amdgcn_s_barrier()
#define PG8_SCHED __builtin_amdgcn_sched_barrier(0)
    Unit cur, nxt; int ui = 0;
    if (!S.next(0, cur)) return;
    f32x4 acc[2][2][4][2];
#pragma unroll
    for (int a = 0; a < 2; ++a)
#pragma unroll
        for (int b = 0; b < 2; ++b)
#pragma unroll
            for (int m = 0; m < 4; ++m)
#pragma unroll
                for (int n = 0; n < 2; ++n) acc[a][b][m][n] = (f32x4){0.f, 0.f, 0.f, 0.f};
    bf16x8 At[4][2], B0[2][2], B1[2][2];
    const char* cA = cur.A; const char* cB = cur.B;
    PG8_GVO(cvo0, cvo1, 0);
    S.a_ready(cur);
    if constexpr (SP2) {
        PG8_STAGE(PG8_SB(0, 0), cB, voffB); PG8_STAGE(PG8_SB(0, 1), cB + hstep, voffB); PG8_STAGE(PG8_SA(0, 0), cA, cvo0); PG8_STAGE(PG8_SA(0, 1), cA, cvo1);
        if (wr == 1) PG8_BAR;
        PG8_WAIT_V(2); PG8_BAR;
        PG8_STAGE(PG8_SB(1, 0), cB + kstep, voffB); PG8_STAGE(PG8_SA(1, 0), cA + kstep, cvo0); PG8_STAGE(PG8_SB(1, 1), cB + hstep + kstep, voffB);
        PG8_WAIT_V(6); PG8_BAR;
    } else {
        PG8_STAGE(PG8_SB(0, 0), cB, voffB); PG8_STAGE(PG8_SA(0, 0), cA, cvo0); PG8_STAGE(PG8_SB(0, 1), cB + hstep, voffB); PG8_STAGE(PG8_SA(0, 1), cA, cvo1);
        if (wr == 1) PG8_BAR;
        PG8_WAIT_V(4); PG8_BAR;
        PG8_STAGE(PG8_SB(1, 0), cB + kstep, voffB); PG8_STAGE(PG8_SA(1, 0), cA + kstep, cvo0); PG8_STAGE(PG8_SB(1, 1), cB + hstep + kstep, voffB);
        PG8_WAIT_V(6); PG8_BAR;
    }
    for (;;) {
        const bool has_next = S.next(ui + 1, nxt);
        const char* nA = has_next ? nxt.A : cA; const char* nB = has_next ? nxt.B : cB;
        if (has_next) PG8_GVO(nvo0, nvo1, ui + 1); else { _Pragma("unroll") for (int _i = 0; _i < 2; ++_i) { nvo0[_i] = cvo0[_i]; nvo1[_i] = cvo1[_i]; } }
        for (int t = 0; t < nt; t += 2) {
            const bool last = (t == nt - 2);
            const char* a1 = cA + (size_t)(t + 1) * kstep;
            const char* a2 = last ? nA : cA + (size_t)(t + 2) * kstep; const char* b2 = last ? nB : cB + (size_t)(t + 2) * kstep;
            const char* a3 = a2 + kstep; const char* b3 = b2 + kstep;
            unsigned x0[2], x1[2];
            _Pragma("unroll") for (int _i = 0; _i < 2; ++_i) { x0[_i] = last ? nvo0[_i] : cvo0[_i]; x1[_i] = last ? nvo1[_i] : cvo1[_i]; }
            if (last && has_next) S.a_ready(nxt);
            if constexpr (SP2) {
            PG8_LDB(B0, 0, 0); PG8_LDB(B1, 0, 1); PG8_SCHED; PG8_LDA(At, 0, 0); PG8_STAGE(PG8_SA(1, 1), a1, cvo1);
            PG8_WAIT_V(8); PG8_WAIT_L(0); PG8_BAR; PG8_MMA(0, 0, At, B0); PG8_MMA(0, 1, At, B1); PG8_BAR; PG8_SCHED;
            PG8_LDA(At, 0, 1); PG8_STAGE(PG8_SB(0, 0), b2, voffB); PG8_STAGE(PG8_SB(0, 1), b2 + hstep, voffB); PG8_STAGE(PG8_SA(0, 0), a2, x0);
            PG8_WAIT_V(8); PG8_WAIT_L(0); PG8_BAR; PG8_MMA(1, 0, At, B0); PG8_MMA(1, 1, At, B1); PG8_BAR; PG8_SCHED;
            PG8_LDB(B0, 1, 0); PG8_LDB(B1, 1, 1); PG8_SCHED; PG8_LDA(At, 1, 0); PG8_STAGE(PG8_SA(0, 1), a2, x1);
            PG8_WAIT_V(8); PG8_WAIT_L(0); PG8_BAR; PG8_MMA(0, 0, At, B0); PG8_MMA(0, 1, At, B1); PG8_BAR; PG8_SCHED;
            PG8_LDA(At, 1, 1); PG8_STAGE(PG8_SB(1, 0), b3, voffB); PG8_STAGE(PG8_SB(1, 1), b3 + hstep, voffB); PG8_STAGE(PG8_SA(1, 0), a3, x0);
            PG8_WAIT_V(8); PG8_WAIT_L(0); PG8_BAR; PG8_MMA(1, 0, At, B0); PG8_MMA(1, 1, At, B1); PG8_BAR; PG8_SCHED;
            } else {
            PG8_LDB(B0, 0, 0); PG8_SCHED; PG8_LDA(At, 0, 0); PG8_STAGE(PG8_SA(1, 1), a1, cvo1);
            PG8_WAIT_L(8); PG8_BAR; PG8_WAIT_L(0); PG8_MMA(0, 0, At, B0); PG8_BAR; PG8_SCHED;
            PG8_LDB(B1, 0, 1); PG8_STAGE(PG8_SB(0, 0), b2, voffB);
            PG8_BAR; PG8_WAIT_L(0); PG8_MMA(0, 1, At, B1); PG8_BAR;
            PG8_LDA(At, 0, 1); PG8_STAGE(PG8_SA(0, 0), a2, x0);
            PG8_BAR; PG8_WAIT_L(0); PG8_MMA(1, 0, At, B0); PG8_BAR; PG8_SCHED;
            PG8_STAGE(PG8_SB(0, 1), b2 + hstep, voffB);
            PG8_WAIT_V(6); PG8_BAR; PG8_MMA(1, 1, At, B1); PG8_BAR;
            PG8_LDB(B0, 1, 0); PG8_SCHED; PG8_LDA(At, 1, 0); PG8_STAGE(PG8_SA(0, 1), a2, x1);
            PG8_WAIT_L(8); PG8_BAR; PG8_WAIT_L(0); PG8_MMA(0, 0, At, B0); PG8_BAR; PG8_SCHED;
            PG8_LDB(B1, 1, 1); PG8_STAGE(PG8_SB(1, 0), b3, voffB);
            PG8_BAR; PG8_WAIT_L(0); PG8_MMA(0, 1, At, B1); PG8_BAR;
            PG8_LDA(At, 1, 1); PG8_STAGE(PG8_SA(1, 0), a3, x0);
            PG8_BAR; PG8_WAIT_L(0); PG8_MMA(1, 0, At, B0); PG8_BAR; PG8_SCHED;
            PG8_STAGE(PG8_SB(1, 1), b3 + hstep, voffB);
            PG8_WAIT_V(6); PG8_BAR; PG8_MMA(1, 1, At, B1); PG8_BAR;
            }
        }
        if constexpr (ALIGN_EPI) { if (wr == 0) PG8_BAR; }
        if constexpr (!Epi::AFTER_DRAIN) { E(acc, cur, wr, wc, fr, fq); S.done(cur); }
        if (!has_next) break;
#pragma unroll
        for (int a = 0; a < 2; ++a)
#pragma unroll
            for (int b = 0; b < 2; ++b)
#pragma unroll
                for (int m = 0; m < 4; ++m)
#pragma unroll
                    for (int n = 0; n < 2; ++n) acc[a][b][m][n] = (f32x4){0.f, 0.f, 0.f, 0.f};
        cur = nxt; cA = nA; cB = nB; ++ui;
        _Pragma("unroll") for (int _i = 0; _i < 2; ++_i) { cvo0[_i] = nvo0[_i]; cvo1[_i] = nvo1[_i]; }
        if constexpr (ALIGN_EPI) { if (wr == 1) PG8_BAR; }
    }
    PG8_WAIT_V(0);
    if constexpr (!ALIGN_EPI) { if (wr == 0) PG8_BAR; }
    PG8_BAR;
    if constexpr (Epi::AFTER_DRAIN) { E.fused(acc, cur, wr, wc, fr, fq, lds, wid, lane); S.done(cur); }
#undef PG8_GVO
#undef PG8_SA
#undef PG8_SB
#undef PG8_STAGE
#undef PG8_LDA
#undef PG8_LDB
#undef PG8_MMA
#undef PG8_WAIT_V
#undef PG8_WAIT_L
#undef PG8_BAR
#undef PG8_SCHED
}
}

constexpr int NWAVES = 8;
constexpr int D = 1024, SEQ = 16384, NBATCH = 2, NMETA = 16;
constexpr int NREAL = NBATCH * SEQ;
constexpr int NTOK0 = NREAL + NMETA;
constexpr int MP = 33024;
constexpr int LP = 16448;
constexpr int NE = 16, DE = 512;
constexpr float ALPHA = 1.4142135623730951f, LN_EPS = 1e-5f;
constexpr float LAM_INIT = 0.35550906759096934f;
constexpr float C2 = 0.18033688011112042f;
constexpr float LOG2E = 1.4426950408889634f;

constexpr size_t MiB = 1u << 20, KiB = 1024;
constexpr size_t WS_CTL = 0, CTL_ZERO_BYTES = 1 * MiB;
constexpr size_t WS_ROPE = 1 * MiB;
constexpr size_t WS_METAH = 3 * MiB;
constexpr size_t WS_ROUTE_E = 3 * MiB + 64 * KiB;
constexpr size_t WS_ROUTE_W = 3 * MiB + 256 * KiB;
constexpr size_t WS_ROUTE_P = 3 * MiB + 576 * KiB;
constexpr size_t WS_WB = 4 * MiB;
constexpr size_t WS_BCNT = 4 * MiB + 128 * KiB;
constexpr size_t WS_TSTART = 4 * MiB + 192 * KiB;
constexpr size_t WS_WPW1 = 9 * MiB, WS_WPW2 = 13 * MiB, WS_WQKV = 15 * MiB, WS_WO = 21 * MiB;
constexpr size_t WS_W13 = 23 * MiB, WS_W2T = 55 * MiB;
constexpr size_t WS_W13B = 202 * MiB, WS_W2TB = 234 * MiB;
constexpr size_t WS_A = 72 * MiB;
constexpr size_t WS_R1 = 137 * MiB;
constexpr size_t WS_R2 = 274 * MiB;
constexpr size_t WS_R3 = 343 * MiB;
constexpr size_t WS_K = WS_R3 + 65 * MiB;
constexpr size_t WS_END = 480 * MiB;
constexpr int CW_KMAX = 1024;
constexpr int CW_BAR = 4096;
constexpr int CW_ROWIDX = 131072;
constexpr int GTAB_OFF = 132096;

constexpr int RING_OFF = 0, RING_BYTES = 131072;
constexpr int LDSCTL_OFF = RING_BYTES, MISC_OFF = LDSCTL_OFF + 320;
constexpr int LDS_BYTES = 147456;

#define GAS __attribute__((address_space(1)))
#define LAS __attribute__((address_space(3)))
typedef unsigned short bf16;
typedef unsigned v4u __attribute__((ext_vector_type(4)));
typedef unsigned v2u __attribute__((ext_vector_type(2)));
typedef float f32x4 __attribute__((ext_vector_type(4)));
typedef float f32x2 __attribute__((ext_vector_type(2)));
typedef float f32x16 __attribute__((ext_vector_type(16)));
typedef short bf16x8 __attribute__((ext_vector_type(8)));
typedef short s16x4 __attribute__((ext_vector_type(4)));
typedef GAS unsigned gu32;
#define RLX_AGENT __ATOMIC_RELAXED, __HIP_MEMORY_SCOPE_AGENT
#define LDS_WAIT() asm volatile("s_waitcnt lgkmcnt(0)" ::: "memory")
#define VM_WAIT() asm volatile("s_waitcnt vmcnt(0)" ::: "memory")
__device__ __forceinline__ unsigned f2bf(float f) { unsigned u = __builtin_bit_cast(unsigned, f); return (u + 0x7fffu + ((u >> 16) & 1u)) >> 16; }
typedef __bf16 bf16x2v __attribute__((ext_vector_type(2)));
__device__ __forceinline__ unsigned pk2(float lo, float hi) { f32x2 v = {lo, hi}; bf16x2v b = __builtin_convertvector(v, bf16x2v); return __builtin_bit_cast(unsigned, b); }
__device__ __forceinline__ float bflo(unsigned x) { return __builtin_bit_cast(float, x << 16); }
__device__ __forceinline__ float bfhi(unsigned x) { return __builtin_bit_cast(float, x & 0xffff0000u); }
__device__ __forceinline__ float fast_exp2(float x) { return __builtin_amdgcn_exp2f(x); }
__device__ __forceinline__ float fast_rcp(float x) { return __builtin_amdgcn_rcpf(x); }
__device__ __forceinline__ float sigmoidf_(float x) { return fast_rcp(1.0f + fast_exp2(-x * LOG2E)); }
template <int CTRL, int ROWMASK> __device__ __forceinline__ float dpp_f(float v) { return __builtin_bit_cast(float, __builtin_amdgcn_update_dpp(0, __builtin_bit_cast(int, v), CTRL, ROWMASK, 0xF, false)); }
__device__ __forceinline__ float wave_sum(float v) {
    v += dpp_f<0x128, 0xF>(v); v += dpp_f<0x124, 0xF>(v); v += dpp_f<0x122, 0xF>(v); v += dpp_f<0x121, 0xF>(v);
    v += dpp_f<0x142, 0xA>(v);
    v += dpp_f<0x143, 0xC>(v);
    return __builtin_bit_cast(float, __builtin_amdgcn_readlane(__builtin_bit_cast(int, v), 63));
}

#define XB_TMO      128
#define XB_XCNT(j)  (256  + 64 * (j))
#define XB_XSUB(j)  (1280 + 64 * (j))
#define XB_XGEN(j)  (2304 + 64 * (j))
#define XB_TOP      3328
#define XB_TOPGEN   3392
#define XCD_BAR_WORDS 3456
#define XB_SPIN_CAP (1u << 20)

__device__ __forceinline__ unsigned xb_ld(unsigned* p)              { return __hip_atomic_load(p, __ATOMIC_RELAXED, __HIP_MEMORY_SCOPE_AGENT); }
__device__ __forceinline__ unsigned xb_add(unsigned* p, unsigned v) { return __hip_atomic_fetch_add(p, v, __ATOMIC_RELAXED, __HIP_MEMORY_SCOPE_AGENT); }
__device__ __forceinline__ unsigned xb_xcc_id() { return (unsigned)__builtin_amdgcn_s_getreg((3 << 11) | 20) & 0xFu; }
#define XB_SPIN(cond, bar) do { unsigned _sp = 0; while (cond) { __builtin_amdgcn_s_sleep(1); \
    if ((++_sp & 255u) == 0u) { if (xb_ld(&(bar)[XB_TMO])) break; if (_sp > XB_SPIN_CAP) { atomicAdd(&(bar)[XB_TMO], 1u); break; } } } } while (0)

struct XcdBarrier {
    unsigned* bar; unsigned x;
    volatile LAS unsigned* st;
};

__device__ __forceinline__ XcdBarrier xcd_barrier_post(unsigned* bar, volatile LAS unsigned* st) {
    XcdBarrier b; b.bar = bar; b.x = xb_xcc_id(); b.st = st;
    if (threadIdx.x == 0) (void)xb_add(&bar[XB_XCNT(b.x)], 1u);
    return b;
}
__device__ __forceinline__ void xcd_barrier_complete(unsigned* bar, unsigned x, unsigned& nloc, unsigned& nx) {
    const unsigned G = gridDim.x * gridDim.y * gridDim.z;
    unsigned sum, cnt, mine, sp = 0u;
    for (;;) {
        sum = 0u; cnt = 0u; mine = 0u;
#pragma unroll
        for (unsigned j = 0; j < 16; ++j) { const unsigned c = xb_ld(&bar[XB_XCNT(j)]); sum += c; cnt += (c > 0u) ? 1u : 0u; mine = (j == x) ? c : mine; }
        if (sum == G) break;
        __builtin_amdgcn_s_sleep(1);
        if ((++sp & 255u) == 0u) { if (xb_ld(&bar[XB_TMO])) break; if (sp > XB_SPIN_CAP) { atomicAdd(&bar[XB_TMO], 1u); break; } }
    }
    nloc = mine > 0u ? mine : 1u; nx = cnt > 0u ? cnt : 1u;
}

__device__ __forceinline__ void xcd_barrier(const XcdBarrier& b) {
    asm volatile("s_waitcnt vmcnt(0)" ::: "memory");
    __syncthreads();
    if (threadIdx.x == 0) {
        unsigned* bar = b.bar;
        __builtin_amdgcn_s_waitcnt(0);
        unsigned nloc = b.st[0], nx = b.st[1];
        if (nloc == 0u) { xcd_barrier_complete(bar, b.x, nloc, nx); b.st[0] = nloc; b.st[1] = nx; }
        const unsigned old = xb_add(&bar[XB_XSUB(b.x)], 1u);
        const unsigned gen = old / nloc;
        if (old + 1u == (gen + 1u) * nloc) {
            __builtin_amdgcn_fence(__ATOMIC_RELEASE, "agent");
            asm volatile("s_waitcnt vmcnt(0)" ::: "memory");
            const unsigned og = xb_add(&bar[XB_TOP], 1u);
            const unsigned tg = og / nx;
            if (og + 1u == (tg + 1u) * nx) xb_add(&bar[XB_TOPGEN], 1u);
            else XB_SPIN(xb_ld(&bar[XB_TOPGEN]) == tg, bar);
            __builtin_amdgcn_fence(__ATOMIC_ACQUIRE, "agent");
            xb_add(&bar[XB_XGEN(b.x)], 1u);
            asm volatile("s_waitcnt vmcnt(0)" ::: "memory");
        } else {
            XB_SPIN(xb_ld(&bar[XB_XGEN(b.x)]) == gen, bar);
            __builtin_amdgcn_fence(__ATOMIC_ACQUIRE, "agent");
            asm volatile("s_waitcnt vmcnt(0)" ::: "memory");
        }
    }
    __syncthreads();
}

struct Frame {
    LAS unsigned char* lds;
    volatile LAS unsigned* MISC;
    gu32* ctl;
    unsigned char* ws;
    int tid, lane, wave;
    int vcu, G;
    const float* in[28];
    float* out;
};
__device__ __forceinline__ float* hrow(const Frame& F, int r) { return r < NREAL ? F.out + (size_t)r * D : (float*)(F.ws + WS_METAH) + (size_t)(r - NREAL) * D; }
__device__ __forceinline__ const float* h0row(const Frame& F, int r) { return r < NREAL ? F.in[0] + (size_t)r * D : F.in[1] + (size_t)(r - NREAL) * D; }

struct DenseOrder {
    const char* A; const char* Bt; size_t tstep; int nM, nN, nwg, G, c;
    __device__ __forceinline__ void init(const void* A_, const void* Bt_, int K, int nM_, int nN_, int G_, int c_) {
        A = (const char*)A_; Bt = (const char*)Bt_; tstep = (size_t)256 * K * 2; nM = nM_; nN = nN_; nwg = nM * nN; G = G_; c = c_; }
    __device__ __forceinline__ bool map(int i, int& pm, int& pn) const {
        const long L = (long)i * G + c; if (L >= nwg) return false;
        int wgid = (int)L; { const int q = nwg / 8, r = nwg % 8, xcd = wgid % 8, off = wgid / 8; wgid = (xcd < r ? xcd * (q + 1) : r * (q + 1) + (xcd - r) * q) + off; }
        const int nig = 8 * nN, gid = wgid / nig, fm = gid * 8, gsz = (nM - fm) < 8 ? (nM - fm) : 8;
        pm = fm + ((wgid % nig) % gsz); pn = (wgid % nig) / gsz; return true;
    }
    __device__ __forceinline__ bool next(int i, pg8::Unit& u) const {
        if (!map(i, u.pm, u.pn)) return false;
        u.A = A + (size_t)u.pm * tstep; u.B = Bt + (size_t)u.pn * tstep; return true; }
    __device__ __forceinline__ void a_ready(const pg8::Unit&) const {}
    __device__ __forceinline__ void done(const pg8::Unit&) const {}
};
struct MoeOrder {
    DenseOrder d; size_t estep; int ts[17]; bool gather;
    __device__ __forceinline__ void init(const void* A_, const void* Bt_, int K, int nN_, size_t estep_, const int* tstart, int G_, int c_) {
#pragma unroll
        for (int e = 0; e < 17; ++e) ts[e] = __builtin_amdgcn_readfirstlane(tstart[e]);
        d.init(A_, Bt_, K, ts[16], nN_, G_, c_); estep = estep_; gather = false; }
    __device__ __forceinline__ bool next(int i, pg8::Unit& u) const {
        if (!d.map(i, u.pm, u.pn)) return false;
        int e = 0;
#pragma unroll
        for (int k = 1; k < 16; ++k) e += (u.pm >= ts[k]) ? 1 : 0;
        u.A = gather ? d.A : d.A + (size_t)u.pm * d.tstep; u.B = d.Bt + (size_t)e * estep + (size_t)u.pn * d.tstep; return true; }
    __device__ __forceinline__ void a_ready(const pg8::Unit&) const {}
    __device__ __forceinline__ void done(const pg8::Unit&) const {}
};

using pg8::Unit;
struct EpiGLU {
    static constexpr bool PERM = true, AFTER_DRAIN = false;
    bf16* U; const float* bias;
    __device__ __forceinline__ void operator()(const f32x4 (&acc)[2][2][4][2], const Unit& u, int wr, int wc, int fr, int fq) const {
        const int row0 = u.pm * 256 + wr * 64 + fr, oc = u.pn * 128 + wc * 32 + 8 * fq;
        f32x4 ba[2], bg[2];
#pragma unroll
        for (int n = 0; n < 2; ++n) { ba[n] = *(const f32x4*)(bias + oc + 4 * n); bg[n] = *(const f32x4*)(bias + D + oc + 4 * n); }
#pragma unroll
        for (int ai = 0; ai < 2; ++ai)
#pragma unroll
            for (int m = 0; m < 4; ++m) {
                float o[8];
#pragma unroll
                for (int n = 0; n < 2; ++n)
#pragma unroll
                    for (int i = 0; i < 4; ++i) { const float a = acc[ai][0][m][n][i] + ba[n][i], g = acc[ai][1][m][n][i] + bg[n][i]; o[4 * n + i] = a * sigmoidf_(g); }
                v4u w; w.x = pk2(o[0], o[1]); w.y = pk2(o[2], o[3]); w.z = pk2(o[4], o[5]); w.w = pk2(o[6], o[7]);
                *(v4u*)(U + (size_t)(row0 + ai * 128 + m * 16) * D + oc) = w;
            }
    }
};
struct EpiSwiGLU {
    static constexpr bool PERM = true, AFTER_DRAIN = false;
    bf16* H;
    __device__ __forceinline__ void operator()(const f32x4 (&acc)[2][2][4][2], const Unit& u, int wr, int wc, int fr, int fq) const {
        const int row0 = u.pm * 256 + wr * 64 + fr, oc = u.pn * 128 + wc * 32 + 8 * fq;
#pragma unroll
        for (int ai = 0; ai < 2; ++ai)
#pragma unroll
            for (int m = 0; m < 4; ++m) {
                float o[8];
#pragma unroll
                for (int n = 0; n < 2; ++n)
#pragma unroll
                    for (int i = 0; i < 4; ++i) { const float a = acc[ai][0][m][n][i], g = acc[ai][1][m][n][i]; o[4 * n + i] = a * sigmoidf_(a) * g; }
                v4u w; w.x = pk2(o[0], o[1]); w.y = pk2(o[2], o[3]); w.z = pk2(o[4], o[5]); w.w = pk2(o[6], o[7]);
                *(v4u*)(H + (size_t)(row0 + ai * 128 + m * 16) * DE + oc) = w;
            }
    }
};
struct EpiBf16 {
    static constexpr bool PERM = true, AFTER_DRAIN = false;
    bf16* O; const float* bias;
    __device__ __forceinline__ void operator()(const f32x4 (&acc)[2][2][4][2], const Unit& u, int wr, int wc, int fr, int fq) const {
        const int row0 = u.pm * 256 + wr * 64 + fr, oc = u.pn * 256 + wc * 32 + 8 * fq;
        f32x4 bv[2][2];
#pragma unroll
        for (int bj = 0; bj < 2; ++bj)
#pragma unroll
            for (int n = 0; n < 2; ++n) bv[bj][n] = bias ? *(const f32x4*)(bias + oc + bj * 128 + 4 * n) : (f32x4){0.f, 0.f, 0.f, 0.f};
#pragma unroll
        for (int ai = 0; ai < 2; ++ai)
#pragma unroll
            for (int m = 0; m < 4; ++m)
#pragma unroll
                for (int bj = 0; bj < 2; ++bj) {
                    const f32x4 v0 = acc[ai][bj][m][0] + bv[bj][0], v1 = acc[ai][bj][m][1] + bv[bj][1];
                    v4u w; w.x = pk2(v0[0], v0[1]); w.y = pk2(v0[2], v0[3]); w.z = pk2(v1[0], v1[1]); w.w = pk2(v1[2], v1[3]);
                    *(v4u*)(O + (size_t)(row0 + ai * 128 + m * 16) * D + oc + bj * 128) = w;
                }
    }
};
template <bool LAYER0> struct EpiResF32 {
    static constexpr bool PERM = false, AFTER_DRAIN = false;
    float* Y; const float* bias; const float* hreal; const float* hmeta; int nvalid;
    __device__ __forceinline__ void operator()(const f32x4 (&acc)[2][2][4][2], const Unit& u, int wr, int wc, int fr, int fq) const {
        const int row0 = u.pm * 256 + wr * 64 + fr, c0 = u.pn * 256 + wc * 32 + 4 * fq;
        f32x4 bv[2][2];
#pragma unroll
        for (int bj = 0; bj < 2; ++bj)
#pragma unroll
            for (int n = 0; n < 2; ++n) bv[bj][n] = bias ? *(const f32x4*)(bias + c0 + bj * 128 + n * 16) : (f32x4){0.f, 0.f, 0.f, 0.f};
#pragma unroll
        for (int ai = 0; ai < 2; ++ai)
#pragma unroll
            for (int m = 0; m < 4; ++m) {
                const int r = row0 + ai * 128 + m * 16;
                if (r < nvalid) {
                    const float* hp = (r < NREAL ? hreal + (size_t)r * D : hmeta + (size_t)(r - NREAL) * D) + c0;
                    float* yp = Y + (size_t)r * D + c0;
#pragma unroll
                    for (int bj = 0; bj < 2; ++bj)
#pragma unroll
                        for (int n = 0; n < 2; ++n) { const f32x4 h = *(const f32x4*)(hp + bj * 128 + n * 16); *(f32x4*)(yp + bj * 128 + n * 16) = acc[ai][bj][m][n] + bv[bj][n] + ALPHA * h; }
                }
            }
    }
};
struct EpiQKV {
    static constexpr bool PERM = true, AFTER_DRAIN = false;
    bf16* Q; bf16* Kb; bf16* Vb; const f32x4* rope; unsigned* kmax;
    __device__ __forceinline__ void operator()(const f32x4 (&acc)[2][2][4][2], const Unit& u, int wr, int wc, int fr, int fq) const {
        const int kind = u.pn >> 2;
        const int cb = (u.pn & 3) * 256 + wc * 32 + 8 * fq;
        const bool meta = (u.pm == 128);
        const int b = u.pm >> 6;
        const bool dorope = (kind != 1) && ((wc & 1) == 0) && (fq < 2);
        float nmax[2] = {0.f, 0.f};
#pragma unroll
        for (int ai = 0; ai < 2; ++ai)
#pragma unroll
            for (int m = 0; m < 4; ++m) {
                const int r = u.pm * 256 + ai * 128 + wr * 64 + m * 16 + fr;
                const bool valid = !meta || (r - NREAL) < NMETA;
                int pos = meta ? (r - NREAL) : NMETA + (r & (SEQ - 1));
                if (!valid) pos = 0;
                f32x4 v[2][2];
#pragma unroll
                for (int bj = 0; bj < 2; ++bj)
#pragma unroll
                    for (int n = 0; n < 2; ++n) v[bj][n] = acc[ai][bj][m][n];
                if (dorope) {
                    const f32x4 cs0 = rope[(size_t)pos * 4 + 2 * fq], cs1 = rope[(size_t)pos * 4 + 2 * fq + 1];
                    const float cc[4] = {cs0[0], cs0[2], cs1[0], cs1[2]}, ss[4] = {cs0[1], cs0[3], cs1[1], cs1[3]};
#pragma unroll
                    for (int bj = 0; bj < 2; ++bj)
#pragma unroll
                        for (int i = 0; i < 4; ++i) { const float t1 = v[bj][0][i], t2 = v[bj][1][i]; v[bj][0][i] = t1 * cc[i] - t2 * ss[i]; v[bj][1][i] = t1 * ss[i] + t2 * cc[i]; }
                }
                if (kind == 0) {
#pragma unroll
                    for (int bj = 0; bj < 2; ++bj) {
                        float ps = 0.f;
#pragma unroll
                        for (int n = 0; n < 2; ++n)
#pragma unroll
                            for (int i = 0; i < 4; ++i) ps += v[bj][n][i] * v[bj][n][i];
                        ps += __shfl_xor(ps, 16); ps += __shfl_xor(ps, 32);
                        if (valid) nmax[bj] = fmaxf(nmax[bj], ps);
                    }
                }
                const float sc = (kind == 2) ? C2 : 1.0f;
#pragma unroll
                for (int bj = 0; bj < 2; ++bj) {
                    const f32x4 v0 = v[bj][0] * sc, v1 = v[bj][1] * sc;
                    v4u w; w.x = pk2(v0[0], v0[1]); w.y = pk2(v0[2], v0[3]); w.z = pk2(v1[0], v1[1]); w.w = pk2(v1[2], v1[3]);
                    const int col = cb + bj * 128;
                    if (kind == 2) { if (!meta) *(v4u*)(Q + (size_t)r * D + col) = w; }
                    else {
                        bf16* dst = (kind == 0) ? Kb : Vb;
                        if (!meta) *(v4u*)(dst + ((size_t)b * LP + 64 + (r & (SEQ - 1))) * D + col) = w;
                        else if (valid) { const int pp = 48 + (r - NREAL); *(v4u*)(dst + (size_t)pp * D + col) = w; *(v4u*)(dst + ((size_t)LP + pp) * D + col) = w; }
                    }
                }
            }
        if (kind == 0) {
#pragma unroll
            for (int bj = 0; bj < 2; ++bj) {
                float mx = nmax[bj];
                mx = fmaxf(mx, __shfl_xor(mx, 1)); mx = fmaxf(mx, __shfl_xor(mx, 2)); mx = fmaxf(mx, __shfl_xor(mx, 4)); mx = fmaxf(mx, __shfl_xor(mx, 8));
                if ((threadIdx.x & 63) == 0) {
                    const int hc = ((u.pn & 3) * 256 + bj * 128 + wc * 32) >> 6, hf = wc & 1;
                    const unsigned bits = __builtin_bit_cast(unsigned, mx);
                    if (!meta) atomicMax(kmax + (b * 16 + hc) * 2 + hf, bits);
                    else { atomicMax(kmax + (0 * 16 + hc) * 2 + hf, bits); atomicMax(kmax + (1 * 16 + hc) * 2 + hf, bits); }
                }
            }
        }
    }
};

__device__ __forceinline__ f32x4 mini_tile(const bf16* A16, const bf16* Bt, int brow0, int K, int lane) {
    const bf16* ap = A16 + (size_t)(lane & 15) * K + 8 * (lane >> 4);
    const bf16* bp = Bt + (size_t)(brow0 + (lane & 15)) * K + 8 * (lane >> 4);
    f32x4 acc = {0.f, 0.f, 0.f, 0.f};
#pragma unroll 8
    for (int k0 = 0; k0 < K; k0 += 32) { const bf16x8 a = *(const bf16x8*)(ap + k0), b = *(const bf16x8*)(bp + k0); acc = __builtin_amdgcn_mfma_f32_16x16x32_bf16(a, b, acc, 0, 0, 0); }
    return acc;
}
__device__ __forceinline__ void mini_glu(Frame& F) {
    const int tix = blockIdx.x * NWAVES + F.wave; if (tix >= 64) return;
    const bf16* A16 = (const bf16*)(F.ws + WS_A) + (size_t)NREAL * D; const bf16* Bt = (const bf16*)(F.ws + WS_WPW1); bf16* U = (bf16*)(F.ws + WS_R2);
    const int c = 16 * tix + (F.lane & 15), ra = 256 * (c >> 7) + (c & 127) - (F.lane & 15);
    const f32x4 aa = mini_tile(A16, Bt, ra, D, F.lane), ag = mini_tile(A16, Bt, ra + 128, D, F.lane);
    const float ba = F.in[3][c], bg = F.in[3][D + c];
#pragma unroll
    for (int i = 0; i < 4; ++i) { const int row = NREAL + 4 * (F.lane >> 4) + i; U[(size_t)row * D + c] = (bf16)f2bf((aa[i] + ba) * sigmoidf_(ag[i] + bg)); }
}
__device__ __forceinline__ void mini_pw2(Frame& F) {
    const int tix = blockIdx.x * NWAVES + F.wave; if (tix >= 64) return;
    const bf16* A16 = (const bf16*)(F.ws + WS_R3) + (size_t)NREAL * D; const bf16* Bt = (const bf16*)(F.ws + WS_WPW2); bf16* Y = (bf16*)(F.ws + WS_R1);
    const int c = 16 * tix + (F.lane & 15);
    const f32x4 a = mini_tile(A16, Bt, 16 * tix, D, F.lane);
    const float bb = F.in[9][c];
#pragma unroll
    for (int i = 0; i < 4; ++i) { const int j = 4 * (F.lane >> 4) + i; Y[(size_t)(NREAL + j) * D + c] = (bf16)f2bf(a[i] + bb); }
}
__device__ __forceinline__ void mini_kv(Frame& F) {
    const int tix = blockIdx.x * NWAVES + F.wave; if (tix >= 128) return;
    const bf16* A16 = (const bf16*)(F.ws + WS_A) + (size_t)NREAL * D; const bf16* Bt = (const bf16*)(F.ws + WS_WQKV);
    const int isv = tix >> 6, t = tix & 63, p = F.lane & 15, c = 16 * t + p;
    f32x4 a = mini_tile(A16, Bt, isv * D + 16 * t, D, F.lane);
    bf16* dst = (bf16*)(F.ws + (isv ? WS_R1 : WS_K));
    if (!isv) {
        if ((t & 3) == 0) {
            const f32x2* rope = (const f32x2*)(F.ws + WS_ROPE);
            const int jj = (p & 3) + 4 * (p >> 3);
#pragma unroll
            for (int i = 0; i < 4; ++i) { const int pos = 4 * (F.lane >> 4) + i; const f32x2 cs = rope[pos * 8 + jj];
                const float own = a[i], oth = __shfl_xor(own, 4);
                a[i] = (p & 4) ? (oth * cs.y + own * cs.x) : (own * cs.x - oth * cs.y); }
        }
        float mx = 0.f;
#pragma unroll
        for (int i = 0; i < 4; ++i) { float ps = a[i] * a[i]; ps += __shfl_xor(ps, 1); ps += __shfl_xor(ps, 2); ps += __shfl_xor(ps, 4); ps += __shfl_xor(ps, 8); mx = fmaxf(mx, ps); }
        mx = fmaxf(mx, __shfl_xor(mx, 16)); mx = fmaxf(mx, __shfl_xor(mx, 32));
        if (F.lane == 0) {
            const unsigned bits = __builtin_bit_cast(unsigned, 2.0f * mx); unsigned* kmax = (unsigned*)(F.ctl + CW_KMAX);
            const int hc = t >> 2, hf = (t >> 1) & 1;
            atomicMax(kmax + (0 * 16 + hc) * 2 + hf, bits); atomicMax(kmax + (1 * 16 + hc) * 2 + hf, bits);
        }
    }
#pragma unroll
    for (int i = 0; i < 4; ++i) { const int pp = 48 + 4 * (F.lane >> 4) + i; const bf16 v = (bf16)f2bf(a[i]); dst[(size_t)pp * D + c] = v; dst[((size_t)LP + pp) * D + c] = v; }
}

template <class RowMap>
__device__ __forceinline__ void transpose_item(const float* W, int K, int N, bf16* WT, const RowMap& rm, LAS float* scr, int item, int lane) {
    const int nblk = N / 32, kb = item / nblk, nb = item % nblk, k0 = 64 * kb, n0 = 32 * nb;
#pragma unroll 8
    for (int i = 0; i < 32; ++i) { const int kk = 2 * i + (lane >> 5); scr[kk * 33 + (lane & 31)] = W[(size_t)(k0 + kk) * N + n0 + (lane & 31)]; }
    LDS_WAIT(); asm volatile("" ::: "memory");
    const int c = lane & 7;
#pragma unroll
    for (int j = 0; j < 4; ++j) { const int n = (lane >> 3) + 8 * j; const LAS float* s = scr + (8 * c) * 33 + n;
        v4u o; o.x = pk2(s[0 * 33], s[1 * 33]); o.y = pk2(s[2 * 33], s[3 * 33]); o.z = pk2(s[4 * 33], s[5 * 33]); o.w = pk2(s[6 * 33], s[7 * 33]);
        *(GAS v4u*)(WT + (size_t)rm(n0 + n) * K + k0 + 8 * c) = o; }
    LDS_WAIT(); asm volatile("" ::: "memory");
}
struct RmId { int off; __device__ __forceinline__ int operator()(int n) const { return off + n; } };
struct RmGlu { int half, part; __device__ __forceinline__ int operator()(int n) const { return 256 * (n >> 7) + 128 * part + (n & 127); } };
struct RmRope { int off; __device__ __forceinline__ int operator()(int n) const { const int dd = n & 63; int p = dd; if (dd >= 4 && dd < 8) p = dd + 4; else if (dd >= 8 && dd < 12) p = dd - 4; return off + (n & ~63) + p; } };

__device__ __forceinline__ void moe_weights_convert(Frame& F, int layer, int gw, int NGW) {
    LAS float* scr = (LAS float*)(F.lds + RING_OFF + F.wave * 16384);
    bf16* W13 = (bf16*)(F.ws + (layer ? WS_W13B : WS_W13)); bf16* W2T = (bf16*)(F.ws + (layer ? WS_W2TB : WS_W2T));
    constexpr int I13 = (D / 64) * (DE / 32), I2 = (DE / 64) * (D / 32);
    for (int it = gw; it < NE * (2 * I13 + I2); it += NGW) {
        const int e = it / (2 * I13 + I2); int r = it % (2 * I13 + I2);
        const size_t woff = ((size_t)layer * NE + e) * (size_t)D * DE;
        if (r < I13) { transpose_item(F.in[25] + woff, D, DE, W13 + (size_t)e * D * D, RmGlu{0, 0}, scr, r, F.lane); continue; } r -= I13;
        if (r < I13) { transpose_item(F.in[26] + woff, D, DE, W13 + (size_t)e * D * D, RmGlu{0, 1}, scr, r, F.lane); continue; } r -= I13;
        transpose_item(F.in[27] + woff, DE, D, W2T + (size_t)e * D * DE, RmId{0}, scr, r, F.lane);
    }
}
__device__ __forceinline__ void sincos_acc(float af, float& c, float& s) {
    const double a = (double)af;
    const double q = __builtin_rint(a * 0.63661977236758134308);
    const double y = (a - q * 1.57079632679489655800) - q * 6.123233995736766036e-17;
    const double y2 = y * y;
    double sp = 1.0 / 1307674368000.0; sp = sp * y2 - 1.0 / 6227020800.0; sp = sp * y2 + 1.0 / 39916800.0; sp = sp * y2 - 1.0 / 362880.0; sp = sp * y2 + 1.0 / 5040.0; sp = sp * y2 - 1.0 / 120.0; sp = sp * y2 + 1.0 / 6.0;
    const double sy = y - y * y2 * sp;
    double cp = 1.0 / 87178291200.0; cp = cp * y2 - 1.0 / 479001600.0; cp = cp * y2 + 1.0 / 3628800.0; cp = cp * y2 - 1.0 / 40320.0; cp = cp * y2 + 1.0 / 720.0; cp = cp * y2 - 1.0 / 24.0; cp = cp * y2 + 0.5;
    const double cy = 1.0 - y2 * cp;
    const int qi = ((int)q) & 3;
    const double sv = (qi == 0) ? sy : (qi == 1) ? cy : (qi == 2) ? -sy : -cy;
    const double cv = (qi == 0) ? cy : (qi == 1) ? -sy : (qi == 2) ? -cy : sy;
    c = (float)cv; s = (float)sv;
}
__device__ __forceinline__ void p0_prologue(Frame& F) {
    LAS float* scr = (LAS float*)(F.lds + RING_OFF + F.wave * 16384);
    const int gw = blockIdx.x * NWAVES + F.wave, NGW = F.G * NWAVES;
    bf16* Wpw1 = (bf16*)(F.ws + WS_WPW1); bf16* Wpw2 = (bf16*)(F.ws + WS_WPW2); bf16* Wqkv = (bf16*)(F.ws + WS_WQKV); bf16* Wo = (bf16*)(F.ws + WS_WO);
    constexpr int I_PW1 = (D / 64) * (2 * D / 32), I_SQ = (D / 64) * (D / 32);
    constexpr int NITEMS = I_PW1 + 5 * I_SQ;
    for (int it = gw; it < NITEMS; it += NGW) {
        int r = it;
        if (r < I_PW1) {
            const int nblk = 2 * D / 32, nb = r % nblk; const int part = (nb * 32) >= D ? 1 : 0;
            const int kb = r / nblk, nbl = nb - part * (D / 32);
            transpose_item(F.in[2] + part * D, D, 2 * D, Wpw1, RmGlu{0, part}, scr, kb * nblk + nbl, F.lane);
            continue; }
        r -= I_PW1;
        if (r < I_SQ) { transpose_item(F.in[8], D, D, Wpw2, RmId{0}, scr, r, F.lane); continue; } r -= I_SQ;
        if (r < I_SQ) { transpose_item(F.in[10], D, D, Wqkv, RmRope{0}, scr, r, F.lane); continue; } r -= I_SQ;
        if (r < I_SQ) { transpose_item(F.in[11], D, D, Wqkv, RmId{D}, scr, r, F.lane); continue; } r -= I_SQ;
        if (r < I_SQ) { transpose_item(F.in[12], D, D, Wqkv, RmRope{2 * D}, scr, r, F.lane); continue; } r -= I_SQ;
        transpose_item(F.in[18], D, D, Wo, RmId{0}, scr, r, F.lane);
    }
    moe_weights_convert(F, 0, gw, NGW);
    bf16* A = (bf16*)(F.ws + WS_A);
    for (int m = gw; m < MP; m += NGW) {
        GAS unsigned long long* o8 = (GAS unsigned long long*)(A + (size_t)m * D) + F.lane;
        if (m < NTOK0) {
            const GAS f32x4* xr = (const GAS f32x4*)h0row(F, m) + F.lane;
#pragma unroll
            for (int j = 0; j < 4; ++j) { const f32x4 v = xr[64 * j]; o8[64 * j] = (unsigned long long)pk2(v.x, v.y) | ((unsigned long long)pk2(v.z, v.w) << 32); }
        } else {
#pragma unroll
            for (int j = 0; j < 4; ++j) o8[64 * j] = 0ull;
        }
    }
    {
        const float inv[8] = {1.0f, 0.1939227432012558f, 0.03760603070259094f, 0.007292664609849453f, 0.0014142135623842478f, 0.00027424818836152554f, 5.318296098266728e-05f, 1.0313386155758053e-05f};
        f32x2* rope = (f32x2*)(F.ws + WS_ROPE);
        for (int idx = blockIdx.x * 512 + F.tid; idx < (SEQ + NMETA) * 8; idx += F.G * 512) {
            const int pos = idx >> 3, j = idx & 7;
            float iv = inv[0];
#pragma unroll
            for (int k = 1; k < 8; ++k) iv = (j == k) ? inv[k] : iv;
            const float ang = (float)pos * iv; float c, s; sincos_acc(ang, c, s);
            rope[idx] = (f32x2){c, s};
        }
    }
}

__device__ __forceinline__ unsigned conv_rowload(const bf16* U, int b, int ch, int pp) {
    const int pc = pp < 0 ? 0 : pp, row = pc < NMETA ? NREAL + pc : b * SEQ + pc - NMETA;
    const unsigned v = *(const unsigned*)(U + (size_t)row * D + ch);
    return pp < 0 ? 0u : v;
}
__device__ __forceinline__ void conv_phase(Frame& F) {
    const bf16* U = (const bf16*)(F.ws + WS_R2); bf16* C = (bf16*)(F.ws + WS_R3);
    const int tid = F.tid, ch = 2 * tid;
    float w0[31], w1[31];
#pragma unroll
    for (int k = 0; k < 31; ++k) { const f32x2 v = *(const f32x2*)(F.in[4] + (size_t)k * D + ch); w0[k] = v.x; w1[k] = v.y; }
    const f32x2 bdw = *(const f32x2*)(F.in[5] + ch), lg = *(const f32x2*)(F.in[6] + ch), lb = *(const f32x2*)(F.in[7] + ch);
    LAS float* red = (LAS float*)(F.lds + RING_OFF);
    LAS float* fin = (LAS float*)(F.lds + RING_OFF + 2048);
    const bool b5 = (F.lane & 32) != 0, b4 = (F.lane & 16) != 0, b3 = (F.lane & 8) != 0, b2 = (F.lane & 4) != 0, b1 = (F.lane & 2) != 0;
    for (int u = blockIdx.x; u < 257; u += F.G) {
        const bool mu = (u == 256);
        const int b = mu ? 0 : (u >> 7), posbase = mu ? 0 : NMETA + (u & 127) * 128, nblk = mu ? 1 : 8;
        unsigned in[46], nx[16];
#define CONV_ROWLOAD(pp) conv_rowload(U, b, ch, (pp))
#pragma unroll
        for (int i = 0; i < 30; ++i) in[i] = CONV_ROWLOAD(posbase - 30 + i);
#pragma unroll
        for (int i = 0; i < 16; ++i) nx[i] = CONV_ROWLOAD(posbase + i);
        for (int kb = 0; kb < nblk; ++kb) {
            const int p0 = posbase + 16 * kb;
#pragma unroll
            for (int i = 0; i < 16; ++i) in[30 + i] = nx[i];
            if (kb + 1 < nblk) {
#pragma unroll
                for (int i = 0; i < 16; ++i) nx[i] = CONV_ROWLOAD(p0 + 16 + i);
            }
            float f0[46], f1[46];
#pragma unroll
            for (int i = 0; i < 46; ++i) { f0[i] = bflo(in[i]); f1[i] = bfhi(in[i]); }
            float a0[16], a1[16];
#pragma unroll
            for (int o = 0; o < 16; ++o) { float x0 = bdw.x, x1 = bdw.y;
#pragma unroll
                for (int k = 0; k < 31; ++k) { x0 += w0[k] * f0[o + k]; x1 += w1[k] * f1[o + k]; }
                a0[o] = x0; a1[o] = x1; }
            float v16[16], v8[8], v4[4], v2[2], v1;
#pragma unroll
            for (int i = 0; i < 16; ++i) { const float sv = a0[i] + a1[i], qv = a0[i] * a0[i] + a1[i] * a1[i]; v16[i] = (b5 ? qv : sv) + __shfl_xor(b5 ? sv : qv, 32); }
#pragma unroll
            for (int i = 0; i < 8; ++i) v8[i] = (b4 ? v16[8 + i] : v16[i]) + __shfl_xor(b4 ? v16[i] : v16[8 + i], 16);
#pragma unroll
            for (int i = 0; i < 4; ++i) v4[i] = (b3 ? v8[4 + i] : v8[i]) + __shfl_xor(b3 ? v8[i] : v8[4 + i], 8);
#pragma unroll
            for (int i = 0; i < 2; ++i) v2[i] = (b2 ? v4[2 + i] : v4[i]) + __shfl_xor(b2 ? v4[i] : v4[2 + i], 4);
            v1 = (b1 ? v2[1] : v2[0]) + __shfl_xor(b1 ? v2[0] : v2[1], 2);
            v1 += __shfl_xor(v1, 1);
            if ((F.lane & 1) == 0) red[F.wave * 32 + (F.lane >> 1)] = v1;
            __syncthreads();
            if (tid < 32) { float t = 0.f;
#pragma unroll
                for (int w = 0; w < 8; ++w) t += red[w * 32 + tid];
                fin[tid] = t; }
            __syncthreads();
#pragma unroll
            for (int o = 0; o < 16; ++o) {
                const float mean = fin[o] * (1.0f / D), var = fmaxf(fin[16 + o] * (1.0f / D) - mean * mean, 0.f), rstd = __builtin_amdgcn_rsqf(var + LN_EPS);
                float y0 = (a0[o] - mean) * rstd * lg.x + lb.x, y1 = (a1[o] - mean) * rstd * lg.y + lb.y;
                y0 = y0 * sigmoidf_(y0); y1 = y1 * sigmoidf_(y1);
                const int pp = p0 + o, row = pp < NMETA ? NREAL + pp : b * SEQ + pp - NMETA;
                *(unsigned*)(C + (size_t)row * D + ch) = pk2(y0, y1);
            }
#pragma unroll
            for (int i = 0; i < 30; ++i) in[i] = in[i + 16];
        }
#undef CONV_ROWLOAD
    }
}

template <int LAYER> __device__ __forceinline__ void ln_route_phase(Frame& F, int nrows) {
    const bf16* Mx = (const bf16*)(F.ws + WS_R1); bf16* A = (bf16*)(F.ws + WS_A);
    unsigned* route_e = (unsigned*)(F.ws + WS_ROUTE_E); f32x2* route_w = (f32x2*)(F.ws + WS_ROUTE_W);
    LAS float* WL = (LAS float*)(F.lds + RING_OFF);
    LAS int* wcnt = (LAS int*)(F.lds + RING_OFF + 20 * 1024 * 4);
    const float* wg = F.in[21] + (size_t)LAYER * D * 4; const float* we = F.in[23] + (size_t)LAYER * D * 16;
    for (int idx = F.tid; idx < D * 4; idx += 512) WL[(idx & 3) * D + (idx >> 2)] = wg[idx];
    for (int idx = F.tid; idx < D * 16; idx += 512) WL[(4 + (idx & 15)) * D + (idx >> 4)] = we[idx];
    __syncthreads();
    const float* gp = F.in[19] + (size_t)(LAYER * 2 + 0) * D; const float* bp = F.in[20] + (size_t)(LAYER * 2 + 0) * D;
    f32x4 gam[4], bet[4];
#pragma unroll
    for (int j = 0; j < 4; ++j) { gam[j] = *(const f32x4*)(gp + F.lane * 4 + 256 * j); bet[j] = *(const f32x4*)(bp + F.lane * 4 + 256 * j); }
    float bgr[4], bex[16];
#pragma unroll
    for (int o = 0; o < 4; ++o) bgr[o] = F.in[22][LAYER * 4 + o];
#pragma unroll
    for (int o = 0; o < 16; ++o) bex[o] = F.in[24][LAYER * 16 + o];
    const int gw = blockIdx.x * NWAVES + F.wave, NGW = F.G * NWAVES;
    int cnt = 0;
    LAS float* ps = (LAS float*)(F.lds + RING_OFF + 82432) + F.wave * (4 * 68);
#define LNR_A(r_, V) do { \
        const GAS v2u* mr_ = (const GAS v2u*)(Mx + (size_t)(r_) * D) + F.lane; \
        const GAS f32x4* hin_ = (const GAS f32x4*)h0row(F, LAYER == 0 ? (r_) : 0) + F.lane; \
        const GAS v2u* hb_ = (const GAS v2u*)(A + (size_t)(r_) * D) + F.lane;     \
        float s_ = 0.f; \
        _Pragma("unroll") for (int j = 0; j < 4; ++j) { const v2u a = mr_[64 * j]; f32x4 h; \
            if (LAYER == 0) h = hin_[64 * j]; else { const v2u hb = hb_[64 * j]; h = (f32x4){bflo(hb.x), bfhi(hb.x), bflo(hb.y), bfhi(hb.y)}; } \
            V[j] = ALPHA * h + (f32x4){bflo(a.x), bfhi(a.x), bflo(a.y), bfhi(a.y)}; s_ += (V[j].x + V[j].y) + (V[j].z + V[j].w); } \
        const float mean_ = wave_sum(s_) * (1.f / D); float s2_ = 0.f; \
        _Pragma("unroll") for (int j = 0; j < 4; ++j) { V[j] = V[j] - mean_; s2_ += (V[j].x * V[j].x + V[j].y * V[j].y) + (V[j].z * V[j].z + V[j].w * V[j].w); } \
        const float rstd_ = __builtin_amdgcn_rsqf(wave_sum(s2_) * (1.f / D) + LN_EPS); \
        GAS unsigned long long* o8_ = (GAS unsigned long long*)(A + (size_t)(r_) * D) + F.lane; \
        _Pragma("unroll") for (int j = 0; j < 4; ++j) { V[j] = V[j] * rstd_ * gam[j] + bet[j]; o8_[64 * j] = (unsigned long long)pk2(V[j].x, V[j].y) | ((unsigned long long)pk2(V[j].z, V[j].w) << 32); } \
    } while (0)
#define ROUTE_DOT4(OUT, V, wrow0) do { \
        _Pragma("unroll") for (int o = 0; o < 4; ++o) { \
            f32x2 p2_ = {0.f, 0.f}; \
            _Pragma("unroll") for (int j = 0; j < 4; ++j) { const f32x4 w = *(const LAS f32x4*)(WL + ((wrow0) + o) * D + F.lane * 4 + 256 * j); \
                p2_ = __builtin_elementwise_fma((f32x2){V[j].x, V[j].y}, (f32x2){w.x, w.y}, p2_); p2_ = __builtin_elementwise_fma((f32x2){V[j].z, V[j].w}, (f32x2){w.z, w.w}, p2_); } \
            OUT[o] = wave_sum(p2_.x + p2_.y); } } while (0)
#define LNR_B(r_, V) do { \
        float lgq[4], el[4]; \
        ROUTE_DOT4(lgq, V, 0); \
        float g0 = lgq[0] + bgr[0]; int gi = 0; \
        _Pragma("unroll") for (int o = 1; o < 4; ++o) { const float x = lgq[o] + bgr[o]; if (x > g0) { g0 = x; gi = o; } } \
        float gs = 0.f; \
        _Pragma("unroll") for (int o = 0; o < 4; ++o) gs += __expf(lgq[o] + bgr[o] - g0); \
        const float gwt = fast_rcp(gs);                              \
        const int giu = __builtin_amdgcn_readfirstlane(gi); \
        ROUTE_DOT4(el, V, 4 + 4 * giu); \
        _Pragma("unroll") for (int j = 0; j < 4; ++j) { float bb = bex[j]; \
            _Pragma("unroll") for (int g = 1; g < 4; ++g) bb = (gi == g) ? bex[4 * g + j] : bb; \
            el[j] += bb; } \
        float m1 = el[0]; int i1 = 0; \
        _Pragma("unroll") for (int j = 1; j < 4; ++j) if (el[j] > m1) { m1 = el[j]; i1 = j; } \
        float m2 = -INFINITY; int i2 = 0; \
        _Pragma("unroll") for (int j = 0; j < 4; ++j) if (j != i1 && el[j] > m2) { m2 = el[j]; i2 = j; } \
        const float p2 = __expf(m2 - m1);                          \
        const float w1 = gwt * fast_rcp(1.0f + p2), w2 = w1 * p2;     \
        const int e0 = __builtin_amdgcn_readfirstlane(gi * 4 + i1), e1 = __builtin_amdgcn_readfirstlane(gi * 4 + i2); \
        const int l0 = __builtin_amdgcn_readlane(cnt, e0); cnt += (F.lane == e0) ? 1 : 0; \
        const int l1 = __builtin_amdgcn_readlane(cnt, e1); cnt += (F.lane == e1) ? 1 : 0; \
        if (F.lane == 0) { route_e[(r_)] = (unsigned)e0 | ((unsigned)e1 << 4) | ((unsigned)l0 << 8) | ((unsigned)l1 << 16); route_w[(r_)] = (f32x2){w1, w2}; } \
    } while (0)
    if (gw < nrows) {
        f32x4 vp[4]; int rp = gw;
        LNR_A(gw, vp);
        for (int r = gw + NGW; r < nrows; r += NGW) {
            f32x4 vn[4];
            LNR_A(r, vn);
            LNR_B(rp, vp);
#pragma unroll
            for (int j = 0; j < 4; ++j) vp[j] = vn[j];
            rp = r;
        }
        LNR_B(rp, vp);
    }
#undef LNR_A
#undef LNR_B
#undef ROUTE_DOT4
    if (F.lane < 16) wcnt[F.wave * 16 + F.lane] = cnt;
    __syncthreads();
    if (F.tid < 16) {
        int* WB = (int*)(F.ws + WS_WB) + (size_t)blockIdx.x * 128; int* BC = (int*)(F.ws + WS_BCNT) + (size_t)blockIdx.x * 16;
        int run = 0;
#pragma unroll
        for (int w = 0; w < 8; ++w) { WB[w * 16 + F.tid] = run; run += wcnt[w * 16 + F.tid]; }
        BC[F.tid] = run;
    }
    __syncthreads();
}

__device__ __forceinline__ void dispatch_phase(Frame& F, int nrows) {
    int* rowidx = (int*)(F.ctl + CW_ROWIDX);
    const unsigned* route_e = (const unsigned*)(F.ws + WS_ROUTE_E); v2u* route_p = (v2u*)(F.ws + WS_ROUTE_P);
    const int* BC = (const int*)(F.ws + WS_BCNT); const int* WB = (const int*)(F.ws + WS_WB) + (size_t)blockIdx.x * 128;
    int* TS = (int*)(F.ws + WS_TSTART);
    LAS int* bc = (LAS int*)(F.lds + RING_OFF);
    LAS int* tot = (LAS int*)(F.lds + RING_OFF + 16384); LAS int* bpre = tot + 16; LAS int* base = tot + 32;
    for (int idx = F.tid; idx < F.G * 16; idx += 512) bc[idx] = BC[idx];
    __syncthreads();
    if (F.tid < 16) { int s = 0, pre = 0; for (int b = 0; b < F.G; ++b) { if (b == (int)blockIdx.x) pre = s; s += bc[b * 16 + F.tid]; } tot[F.tid] = s; bpre[F.tid] = pre; }
    __syncthreads();
    if (F.tid == 0) { int t = 0; for (int e = 0; e < 16; ++e) { if (blockIdx.x == 0) TS[e] = t; base[e] = t * 256 + bpre[e]; t += (tot[e] + 255) >> 8; } if (blockIdx.x == 0) TS[16] = t; }
    __syncthreads();
    const int mybase = (F.lane < 16) ? base[F.lane] + WB[F.wave * 16 + F.lane] : 0;
    const int gw = blockIdx.x * NWAVES + F.wave, NGW = F.G * NWAVES;
    for (int r = gw; r < nrows; r += NGW) {
        const unsigned re = __builtin_amdgcn_readfirstlane(route_e[r]);
        const int e0 = re & 15, e1 = (re >> 4) & 15, l0 = (re >> 8) & 255, l1 = (re >> 16) & 255;
        const int pos0 = __builtin_amdgcn_readlane(mybase, e0) + l0, pos1 = __builtin_amdgcn_readlane(mybase, e1) + l1;
        if (F.lane == 0) { route_p[r] = (v2u){(unsigned)pos0, (unsigned)pos1}; rowidx[pos0] = r; rowidx[pos1] = r; }
    }
    __syncthreads();
}

template <int LAYER, bool FINAL> __device__ __forceinline__ void ln_combine_phase(Frame& F, int nrows) {
    const bf16* Ys = (const bf16*)(F.ws + WS_R3); bf16* A = (bf16*)(F.ws + WS_A);
    const f32x2* route_w = (const f32x2*)(F.ws + WS_ROUTE_W); const v2u* route_p = (const v2u*)(F.ws + WS_ROUTE_P);
    const float* gp = F.in[19] + (size_t)(LAYER * 2 + 1) * D; const float* bp = F.in[20] + (size_t)(LAYER * 2 + 1) * D;
    f32x4 gam[4], bet[4];
#pragma unroll
    for (int j = 0; j < 4; ++j) { gam[j] = *(const f32x4*)(gp + F.lane * 4 + 256 * j); bet[j] = *(const f32x4*)(bp + F.lane * 4 + 256 * j); }
    const int gw = blockIdx.x * NWAVES + F.wave, NGW = F.G * NWAVES;
    for (int r = gw; r < nrows; r += NGW) {
        const f32x2 cw = route_w[r]; const v2u ps = route_p[r];
        const GAS v2u* hb = (const GAS v2u*)(A + (size_t)r * D) + F.lane;
        GAS f32x4* hr = (GAS f32x4*)(F.out + (size_t)(FINAL ? r : 0) * D) + F.lane;
        const GAS v2u* y0 = (const GAS v2u*)(Ys + (size_t)ps.x * D) + F.lane; const GAS v2u* y1 = (const GAS v2u*)(Ys + (size_t)ps.y * D) + F.lane;
        f32x4 v[4]; float s = 0.f;
#pragma unroll
        for (int j = 0; j < 4; ++j) {
            const v2u hq = hb[64 * j]; const f32x4 h = {bflo(hq.x), bfhi(hq.x), bflo(hq.y), bfhi(hq.y)}; const v2u a = y0[64 * j], b = y1[64 * j];
            const f32x4 fa = {bflo(a.x), bfhi(a.x), bflo(a.y), bfhi(a.y)}, fb = {bflo(b.x), bfhi(b.x), bflo(b.y), bfhi(b.y)};
            v[j] = ALPHA * h + (cw.x * fa + cw.y * fb);
            s += (v[j].x + v[j].y) + (v[j].z + v[j].w); }
        const float mean = wave_sum(s) * (1.f / D); float s2 = 0.f;
#pragma unroll
        for (int j = 0; j < 4; ++j) { v[j] = v[j] - mean; s2 += (v[j].x * v[j].x + v[j].y * v[j].y) + (v[j].z * v[j].z + v[j].w * v[j].w); }
        const float rstd = __builtin_amdgcn_rsqf(wave_sum(s2) * (1.f / D) + LN_EPS);
        GAS unsigned long long* o8 = (GAS unsigned long long*)(A + (size_t)r * D) + F.lane;
#pragma unroll
        for (int j = 0; j < 4; ++j) { v[j] = v[j] * rstd * gam[j] + bet[j]; if (FINAL) hr[64 * j] = v[j];
            if (!FINAL) o8[64 * j] = (unsigned long long)pk2(v[j].x, v[j].y) | ((unsigned long long)pk2(v[j].z, v[j].w) << 32); }
    }
}

namespace att {
constexpr int KOFF = 0, VOFF = 49152, XOFF = 98304, SLOT = 16384;
typedef __bf16 bf16x2_t __attribute__((ext_vector_type(2)));
__device__ __forceinline__ unsigned cvtpk_s(float lo, float hi) { f32x2 v = {lo, hi}; bf16x2_t b = __builtin_convertvector(v, bf16x2_t); return __builtin_bit_cast(unsigned, b); }
__device__ __forceinline__ bf16x8 packp(const f32x16& p, int s) {
    v4u w; w.x = cvtpk_s(p[8 * s + 0], p[8 * s + 1]); w.y = cvtpk_s(p[8 * s + 2], p[8 * s + 3]); w.z = cvtpk_s(p[8 * s + 4], p[8 * s + 5]); w.w = cvtpk_s(p[8 * s + 6], p[8 * s + 7]);
    return __builtin_bit_cast(bf16x8, w);
}
__device__ __forceinline__ void glds16(const void* gsrc, unsigned lds_dst) { unsigned keep;
    asm volatile("s_mov_b32 %0, m0\n\ts_mov_b32 m0, %2\n\ts_nop 0\n\tglobal_load_lds_dwordx4 %1, off\n\ts_mov_b32 m0, %0" : "=&s"(keep) : "v"(gsrc), "s"(lds_dst) : "memory"); }
#define ATT_BAR_V(N) asm volatile("s_waitcnt vmcnt(" #N ") lgkmcnt(0)\n\ts_barrier" ::: "memory")
#define ATT_BAR() asm volatile("s_waitcnt lgkmcnt(0)\n\ts_barrier" ::: "memory")
typedef short v4i16_t __attribute__((ext_vector_type(4)));
__device__ __forceinline__ s16x4 vtr(LAS const unsigned char* p) { return __builtin_bit_cast(s16x4, __builtin_amdgcn_ds_read_tr16_b64_v4i16((LAS v4i16_t*)p)); }

__device__ __forceinline__ void qk_tile(f32x16& s0, f32x16& s1, LAS const unsigned char* kb, int hi, int kx, const bf16x8 (&qf)[4], const f32x16& negv) {
#pragma unroll
    for (int d0 = 0; d0 < 4; ++d0) {
        const int co = ((2 * d0 + hi) ^ kx) << 4;
        const bf16x8 kf0 = *(LAS const bf16x8*)(kb + co), kf1 = *(LAS const bf16x8*)(kb + 4096 + co);
        s0 = __builtin_amdgcn_mfma_f32_32x32x16_bf16(kf0, qf[d0], d0 == 0 ? negv : s0, 0, 0, 0);
        s1 = __builtin_amdgcn_mfma_f32_32x32x16_bf16(kf1, qf[d0], d0 == 0 ? negv : s1, 0, 0, 0);
    }
}
template <bool FIRST> __device__ __forceinline__ float softmax_pack(f32x16& s0, f32x16& s1, bf16x8 (&P)[4]) {
#pragma unroll
    for (int r = 0; r < 16; ++r) { s0[r] = FIRST ? 0.f : fast_exp2(s0[r]); s1[r] = (FIRST && r < 8) ? 0.f : fast_exp2(s1[r]); }
    float sa = 0.f, sb = 0.f;
#pragma unroll
    for (int r = 0; r < 16; ++r) { sa += s0[r]; asm volatile("" : "+v"(sa)); sb += s1[r]; asm volatile("" : "+v"(sb)); }
    P[0] = packp(s0, 0); P[1] = packp(s0, 1); P[2] = packp(s1, 0); P[3] = packp(s1, 1);
    return sa + sb;
}
__device__ __forceinline__ void pv_tile(f32x16 (&Oa)[4], LAS const unsigned char* va0, LAS const unsigned char* va1, const bf16x8 (&P)[4]) {
#pragma unroll
    for (int dblk = 0; dblk < 4; ++dblk)
#pragma unroll
        for (int hs = 0; hs < 4; ++hs) {
            const s16x4 a0 = vtr(va0 + 4096 * hs + 512 * dblk);
            const s16x4 a1 = vtr(va1 + 4096 * hs + 2048 + 512 * dblk);
            const bf16x8 vf = {a0[0], a0[1], a0[2], a0[3], a1[0], a1[1], a1[2], a1[3]};
            Oa[dblk] = __builtin_amdgcn_mfma_f32_32x32x16_bf16(vf, P[hs], Oa[dblk], 0, 0, 0);
        }
}

__device__ __forceinline__ void mseg(f32x16& s0, f32x16& s1, f32x16 (&Oa)[4], LAS const unsigned char* kb, int hi, int kx, const bf16x8 (&qf)[4], const f32x16& negv,
                                     LAS const unsigned char* va0, LAS const unsigned char* va1, const bf16x8 (&P)[4]) {
    bf16x8 kf0[4], kf1[4];
#pragma unroll
    for (int d0 = 0; d0 < 4; ++d0) { const int co = ((2 * d0 + hi) ^ kx) << 4; kf0[d0] = *(LAS const bf16x8*)(kb + co); kf1[d0] = *(LAS const bf16x8*)(kb + 4096 + co); }
    s16x4 ga0[4], ga1[4], gb0[4], gb1[4];
#define VGRP(A0, A1, dblk) do { _Pragma("unroll") for (int hs = 0; hs < 4; ++hs) { A0[hs] = vtr(va0 + 4096 * hs + 512 * (dblk)); A1[hs] = vtr(va1 + 4096 * hs + 2048 + 512 * (dblk)); } } while (0)
#define PVGRP(A0, A1, dblk) do { _Pragma("unroll") for (int hs = 0; hs < 4; ++hs) { const bf16x8 vf = {A0[hs][0], A0[hs][1], A0[hs][2], A0[hs][3], A1[hs][0], A1[hs][1], A1[hs][2], A1[hs][3]}; \
        Oa[dblk] = __builtin_amdgcn_mfma_f32_32x32x16_bf16(vf, P[hs], Oa[dblk], 0, 0, 0); } } while (0)
    VGRP(ga0, ga1, 0);
    __builtin_amdgcn_sched_barrier(0);
#pragma unroll
    for (int d0 = 0; d0 < 4; ++d0) {
        s0 = __builtin_amdgcn_mfma_f32_32x32x16_bf16(kf0[d0], qf[d0], d0 == 0 ? negv : s0, 0, 0, 0);
        s1 = __builtin_amdgcn_mfma_f32_32x32x16_bf16(kf1[d0], qf[d0], d0 == 0 ? negv : s1, 0, 0, 0);
    }
    __builtin_amdgcn_sched_barrier(0);
    VGRP(gb0, gb1, 1); __builtin_amdgcn_sched_barrier(0); PVGRP(ga0, ga1, 0); __builtin_amdgcn_sched_barrier(0);
    VGRP(ga0, ga1, 2); __builtin_amdgcn_sched_barrier(0); PVGRP(gb0, gb1, 1); __builtin_amdgcn_sched_barrier(0);
    VGRP(gb0, gb1, 3); __builtin_amdgcn_sched_barrier(0); PVGRP(ga0, ga1, 2); __builtin_amdgcn_sched_barrier(0);
    PVGRP(gb0, gb1, 3);
#undef VGRP
#undef PVGRP
}

template <int VAR> __device__ __forceinline__ void attn_unit(Frame& F, int b, int h, int t, float lam) {
    const bf16* Q = (const bf16*)(F.ws + WS_R3); const bf16* Kb = (const bf16*)(F.ws + WS_K); const bf16* Vb = (const bf16*)(F.ws + WS_R1);
    bf16* O = (bf16*)(F.ws + (VAR ? WS_A : WS_R2));
    const unsigned* kmax = (const unsigned*)(F.ctl + CW_KMAX);
    LAS unsigned char* lds = F.lds + RING_OFF;
    int lane = F.lane; asm volatile("" : "+v"(lane));
    const int w = F.wave, r32 = lane & 31, hi = lane >> 5;
    const int g = w & 3, c = w >> 2;
    const int qrow = b * SEQ + 128 * t + 32 * g + r32;
    const int NT = 2 * t + 3, jmax = 2 * t + 1 + (g >> 1);
    const bf16* kg; const bf16* vg0; const bf16* vg1;
    {
        const int row = 8 * w + (lane >> 3), sc = (lane & 7) ^ ((row >> 1) & 7);
        kg = Kb + ((size_t)b * LP + row) * D + h * 128 + sc * 8;
        const int rr = (lane >> 2) & 7, x = lane & 3, sub = lane >> 5;
        { const int q = w, rg = q >> 1, cp = q & 1, rowv = 8 * rg + rr, ch = 4 * (2 * cp + sub) + (x ^ ((rowv >> 2) & 3)); vg0 = Vb + ((size_t)b * LP + rowv) * D + h * 128 + ch * 8; }
        { const int q = w + 8, rg = q >> 1, cp = q & 1, rowv = 8 * rg + rr, ch = 4 * (2 * cp + sub) + (x ^ ((rowv >> 2) & 3)); vg1 = Vb + ((size_t)b * LP + rowv) * D + h * 128 + ch * 8; }
    }
    const unsigned ldsb = (unsigned)(size_t)lds;
#define DMA_K(j, slot) do { glds16(kg + (size_t)(j) * 64 * D, (unsigned)__builtin_amdgcn_readfirstlane(ldsb + KOFF + (slot) + w * 1024)); \
                            glds16(kg + (size_t)(j) * 64 * D + 64, (unsigned)__builtin_amdgcn_readfirstlane(ldsb + KOFF + (slot) + 8192 + w * 1024)); } while (0)
#define DMA_V(j, slot) do { glds16(vg0 + (size_t)(j) * 64 * D, (unsigned)__builtin_amdgcn_readfirstlane(ldsb + VOFF + (slot) + w * 1024)); \
                            glds16(vg1 + (size_t)(j) * 64 * D, (unsigned)__builtin_amdgcn_readfirstlane(ldsb + VOFF + (slot) + 8192 + w * 1024)); } while (0)
    DMA_K(0, 0); DMA_V(0, 0); DMA_K(1, SLOT); DMA_V(1, SLOT); DMA_K(2, 2 * SLOT);
    bf16x8 qf[4]; float negm;
    {
        float n2 = 0.f;
#pragma unroll
        for (int d0 = 0; d0 < 4; ++d0) {
            const v4u q = *(const v4u*)(Q + (size_t)qrow * D + h * 128 + c * 64 + d0 * 16 + hi * 8);
            qf[d0] = __builtin_bit_cast(bf16x8, q);
            const float x0 = bflo(q.x), x1 = bfhi(q.x), x2 = bflo(q.y), x3 = bfhi(q.y), x4 = bflo(q.z), x5 = bfhi(q.z), x6 = bflo(q.w), x7 = bfhi(q.w);
            n2 += (x0 * x0 + x1 * x1) + (x2 * x2 + x3 * x3) + (x4 * x4 + x5 * x5) + (x6 * x6 + x7 * x7); }
        n2 += __shfl_xor(n2, 32);
        const float ka = __builtin_bit_cast(float, kmax[(b * 16 + h * 2 + c) * 2 + 0]), kb2 = __builtin_bit_cast(float, kmax[(b * 16 + h * 2 + c) * 2 + 1]);
        negm = -(sqrtf(n2) * sqrtf(ka + kb2) * 1.01f + 0.01f);
    }
    f32x16 Oa[4];
#pragma unroll
    for (int i = 0; i < 4; ++i) Oa[i] = (f32x16){};
    float lsum = 0.f;
    f32x16 negv;
#pragma unroll
    for (int r = 0; r < 16; ++r) negv[r] = negm;
    asm volatile("" : "+v"(negv));
    const int kx = (r32 >> 1) & 7;
    const int pq = (lane & 15) >> 2, pp = lane & 3, blk = (lane >> 4) & 1;
    const int vb0 = 64 * (4 * hi + pq) + 16 * ((2 * blk + (pp >> 1)) ^ (hi + 0)) + 8 * (pp & 1);
    const int vb1 = 64 * (4 * hi + pq) + 16 * ((2 * blk + (pp >> 1)) ^ (hi + 2)) + 8 * (pp & 1);
    LAS const unsigned char* kbase = lds + KOFF + c * 8192 + r32 * 128;
    LAS const unsigned char* vbase0 = lds + VOFF + vb0;
    LAS const unsigned char* vbase1 = lds + VOFF + vb1;
    bf16x8 P[4];
    f32x16 s0, s1;
    ATT_BAR_V(0);
    qk_tile(s0, s1, kbase, hi, kx, qf, negv);
    lsum += softmax_pack<true>(s0, s1, P);
    if (c == 1) ATT_BAR();
    int sk = 0, sk1 = SLOT, sv2 = 2 * SLOT;
#pragma unroll 1
    for (int s = 0; s < NT; ++s) {
        if (s <= jmax) {

            mseg(s0, s1, Oa, kbase + sk1, hi, kx, qf, negv, vbase0 + sk, vbase1 + sk, P);

        }
        if (c == 1) ATT_BAR_V(0); else ATT_BAR();
        if (!(VAR & 2)) { if (s + 3 < NT) DMA_K(s + 3, sk); if (s + 2 < NT) DMA_V(s + 2, sv2); }
        if (s < jmax) lsum += softmax_pack<false>(s0, s1, P);
        if (c == 0) { if (s + 3 < NT) ATT_BAR_V(4); else ATT_BAR_V(0); } else ATT_BAR();
        { const int tmp = sk; sk = sk1; sk1 = sv2; sv2 = tmp; }
    }
    if (c == 0) ATT_BAR();
#undef DMA_K
#undef DMA_V
    lsum += __shfl_xor(lsum, 32);
    LAS float* X = (LAS float*)(lds + XOFF) + g * 2048 + lane;
    const float sc = (c == 1) ? lam / lsum : 1.0f / lsum;
    float ss = 0.f;
#pragma unroll
    for (int p = 0; p < 2; ++p) {
        if (c == 1) {
#pragma unroll
            for (int d2 = 0; d2 < 2; ++d2)
#pragma unroll
                for (int r = 0; r < 16; ++r) X[(d2 * 16 + r) * 64] = Oa[2 * p + d2][r] * sc;
        }
        __syncthreads();
        if (c == 0) {
#pragma unroll
            for (int d2 = 0; d2 < 2; ++d2)
#pragma unroll
                for (int r = 0; r < 16; ++r) { const float o = Oa[2 * p + d2][r] * sc - X[(d2 * 16 + r) * 64]; Oa[2 * p + d2][r] = o; ss += o * o; }
        }
        __syncthreads();
    }
    if (c == 0) {
        ss += __shfl_xor(ss, 32);
        const float rn = (1.0f / sqrtf(ss * (1.0f / 128.0f) + LN_EPS)) * (1.0f - LAM_INIT);
        const float* sg = F.in[17];
        bf16* orow = O + (size_t)qrow * D + h * 128;
#pragma unroll
        for (int dblk = 0; dblk < 4; ++dblk)
#pragma unroll
            for (int rq = 0; rq < 4; ++rq) {
                const int d0 = 32 * dblk + 8 * rq + 4 * hi;
                const f32x4 gg = *(const f32x4*)(sg + d0);
                v2u wv; wv.x = pk2(Oa[dblk][4 * rq + 0] * rn * gg.x, Oa[dblk][4 * rq + 1] * rn * gg.y); wv.y = pk2(Oa[dblk][4 * rq + 2] * rn * gg.z, Oa[dblk][4 * rq + 3] * rn * gg.w);
                *(v2u*)(orow + d0) = wv;
            }
    }
}
template <int VAR> __device__ __forceinline__ void attn_phase(Frame& F) {
    const float d1 = wave_sum(F.in[13][F.lane] * F.in[14][F.lane]), d2 = wave_sum(F.in[15][F.lane] * F.in[16][F.lane]);
    const float lam = __expf(d1) - __expf(d2) + LAM_INIT;
    for (int pi = F.vcu; pi < 1024; pi += F.G) {
        const int bh = pi >> 6, tp = pi & 63;
#pragma unroll 1
        for (int k = 0; k < 2; ++k) attn_unit<VAR>(F, bh >> 3, bh & 7, k ? 127 - tp : tp, lam);
    }
}
}

constexpr int N_PHASES = 17;
struct Args { const float* in[28]; float* out; unsigned char* ws; int ph_lo, ph_hi, li, pad; };
__global__ void __launch_bounds__(NWAVES * 64, 2) mk_fwd(Args args) {
    extern __shared__ __attribute__((aligned(16))) unsigned char lds[];
    Frame F;
    F.lds = (LAS unsigned char*)lds;
    F.MISC = (volatile LAS unsigned*)(F.lds + MISC_OFF);
    F.tid = threadIdx.x; F.lane = F.tid & 63; F.wave = __builtin_amdgcn_readfirstlane(F.tid >> 6);
    F.G = gridDim.x; { const int bx = blockIdx.x; F.vcu = (F.G % 8 == 0) ? (bx % 8) * (F.G / 8) + bx / 8 : bx; }
    F.ws = args.ws; F.ctl = (gu32*)(args.ws + WS_CTL); F.out = args.out;
#pragma unroll
    for (int i = 0; i < 28; ++i) F.in[i] = args.in[i];
    for (int u = F.tid; u < (LDS_BYTES - LDSCTL_OFF) / 4; u += NWAVES * 64) ((LAS unsigned*)(F.lds + LDSCTL_OFF))[u] = 0u;
    __syncthreads();
    const bool one_phase = (args.ph_hi - args.ph_lo) == 1;
    XcdBarrier bar; bar.bar = (unsigned*)(F.ctl + CW_BAR) + args.li * XCD_BAR_WORDS; bar.x = 0; bar.st = nullptr;
    if (!one_phase) bar = xcd_barrier_post((unsigned*)(F.ctl + CW_BAR) + args.li * XCD_BAR_WORDS, F.MISC + 8);
    const int lo = args.ph_lo, hi = args.ph_hi;
#ifndef PHMASK
#define PHMASK 0x1ffff
#endif
#define IN(k) ((((PHMASK) >> (k)) & 1) && lo <= (k) && (k) < hi)
#define SEAM(k) do { if (IN(k) && IN((k) + 1)) xcd_barrier(bar); } while (0)
    unsigned char* ws = args.ws;
    bf16* A = (bf16*)(ws + WS_A);
    const int* TS = (const int*)(ws + WS_TSTART);

    if (IN(0)) { p0_prologue(F); SEAM(0); }
    if (IN(1)) {
        DenseOrder S; S.init(A, ws + WS_WPW1, D, NREAL / 256, 8, F.G, (int)blockIdx.x);
        EpiGLU E{(bf16*)(ws + WS_R2), F.in[3]};
        pg8::gemm_phase<EpiGLU, DenseOrder, true, true>(F.lds + RING_OFF, D, S, E);
        mini_glu(F);
        SEAM(1);
    }
    if (IN(2)) { conv_phase(F); SEAM(2); }
    if (IN(3)) {
        DenseOrder S; S.init(ws + WS_R3, ws + WS_WPW2, D, NREAL / 256, 4, F.G, (int)blockIdx.x);
        EpiBf16 E{(bf16*)(ws + WS_R1), F.in[9]};
        pg8::gemm_phase<EpiBf16, DenseOrder, true, true>(F.lds + RING_OFF, D, S, E);
        mini_pw2(F);
        SEAM(3);
    }
    if (IN(4)) { ln_route_phase<0>(F, NTOK0); SEAM(4); }
    if (IN(5)) { dispatch_phase(F, NTOK0); SEAM(5); }
    if (IN(6)) {
        MoeOrder S; S.init(A, ws + WS_W13, D, 4, (size_t)D * D * 2, TS, F.G, (int)blockIdx.x); S.gather = true;
        LAS int* gtab = (LAS int*)(F.lds + GTAB_OFF);
        { const int* rowidx = (const int*)(F.ctl + CW_ROWIDX); pg8::Unit gu;
#pragma unroll
          for (int i = 0; i < 6; ++i) if (S.next(i, gu) && F.tid < 256) gtab[i * 256 + F.tid] = rowidx[gu.pm * 256 + F.tid];
          __syncthreads(); }
        EpiSwiGLU E{(bf16*)(ws + WS_R2)};
        pg8::gemm_phase<EpiSwiGLU, MoeOrder, true, true, true>(F.lds + RING_OFF, D, S, E, gtab);
        {
            const int nlate = S.d.nwg - 4 * F.G;
            if (nlate <= 0 || nlate >= F.G) moe_weights_convert(F, 1, blockIdx.x * NWAVES + F.wave, F.G * NWAVES);
            else if ((int)blockIdx.x >= nlate) moe_weights_convert(F, 1, ((int)blockIdx.x - nlate) * NWAVES + F.wave, (F.G - nlate) * NWAVES);
        }
        SEAM(6);
    }
    if (IN(7)) {
        MoeOrder S; S.init(ws + WS_R2, ws + WS_W2T, DE, 4, (size_t)D * DE * 2, TS, F.G, (int)blockIdx.x);
        EpiBf16 E{(bf16*)(ws + WS_R3), nullptr};
        pg8::gemm_phase<EpiBf16, MoeOrder, true, true>(F.lds + RING_OFF, DE, S, E);
        SEAM(7);
    }
    if (IN(8)) {
        ln_combine_phase<0, false>(F, NTOK0);
        SEAM(8);
    }
    if (IN(9)) {
        if (blockIdx.x == 0) {
            for (int i = F.tid; i < 2 * 2 * 48 * 128; i += 512) { const int which = i / (2 * 48 * 128), rem = i % (2 * 48 * 128), bb = rem / (48 * 128), o = rem % (48 * 128);
                v4u* p = (v4u*)((which ? ws + WS_R1 : ws + WS_K) + (size_t)bb * LP * D * 2) + o; *p = (v4u){0u, 0u, 0u, 0u}; }
        }
        DenseOrder S; S.init(A, ws + WS_WQKV, D, NREAL / 256, 12, F.G, (int)blockIdx.x);
        EpiQKV E{(bf16*)(ws + WS_R3), (bf16*)(ws + WS_K), (bf16*)(ws + WS_R1), (const f32x4*)(ws + WS_ROPE), (unsigned*)(F.ctl + CW_KMAX)};
        pg8::gemm_phase<EpiQKV, DenseOrder, true, true>(F.lds + RING_OFF, D, S, E);
        mini_kv(F);
        SEAM(9);
    }
#ifndef MK_ATT_PROBE
#define MK_ATT_PROBE 0
#endif
    if (IN(10)) { att::attn_phase<0>(F); if (MK_ATT_PROBE) { __syncthreads(); att::attn_phase<MK_ATT_PROBE>(F); } SEAM(10); }
    if (IN(11)) {
        DenseOrder S; S.init(ws + WS_R2, ws + WS_WO, D, NREAL / 256, 4, F.G, (int)blockIdx.x);
        EpiBf16 E{(bf16*)(ws + WS_R1), nullptr};
        pg8::gemm_phase<EpiBf16, DenseOrder, true, true>(F.lds + RING_OFF, D, S, E);
        SEAM(11);
    }
    if (IN(12)) { ln_route_phase<1>(F, NREAL); SEAM(12); }
    if (IN(13)) { dispatch_phase(F, NREAL); SEAM(13); }
    if (IN(14)) {
        MoeOrder S; S.init(A, ws + WS_W13B, D, 4, (size_t)D * D * 2, TS, F.G, (int)blockIdx.x); S.gather = true;
        LAS int* gtab = (LAS int*)(F.lds + GTAB_OFF);
        { const int* rowidx = (const int*)(F.ctl + CW_ROWIDX); pg8::Unit gu;
#pragma unroll
          for (int i = 0; i < 6; ++i) if (S.next(i, gu) && F.tid < 256) gtab[i * 256 + F.tid] = rowidx[gu.pm * 256 + F.tid];
          __syncthreads(); }
        EpiSwiGLU E{(bf16*)(ws + WS_R2)};
        pg8::gemm_phase<EpiSwiGLU, MoeOrder, true, true, true>(F.lds + RING_OFF, D, S, E, gtab);
        SEAM(14);
    }
    if (IN(15)) {
        MoeOrder S; S.init(ws + WS_R2, ws + WS_W2TB, DE, 4, (size_t)D * DE * 2, TS, F.G, (int)blockIdx.x);
        EpiBf16 E{(bf16*)(ws + WS_R3), nullptr};
        pg8::gemm_phase<EpiBf16, MoeOrder, true, true>(F.lds + RING_OFF, DE, S, E);
        SEAM(15);
    }
    if (IN(16)) { ln_combine_phase<1, true>(F, NREAL); }
#ifdef MK_DUMP
    if (lo == 17) {
        const int gw = blockIdx.x * NWAVES + F.wave, NGW = F.G * NWAVES;
        const bf16* Qd = (const bf16*)(ws + WS_R3); const bf16* Kd = (const bf16*)(ws + WS_K); const bf16* Vd = (const bf16*)(ws + WS_R1); const bf16* Od = (const bf16*)(ws + WS_R2);
        for (int r = gw; r < NREAL; r += NGW) {
            const int b = r >> 14, sq = r & (SEQ - 1);
            for (int j = 0; j < 16; ++j) { const int c = F.lane + 64 * j;
                float v = 0.f;
                if (MK_DUMP == 1) v = bflo(Qd[(size_t)r * D + c]) + bflo(Kd[((size_t)b * LP + 64 + sq) * D + c]) + bflo(Vd[((size_t)b * LP + 64 + sq) * D + c]);
                if (MK_DUMP == 2) v = bflo(Od[(size_t)r * D + c]);
                if (MK_DUMP == 4) { v = 0.f;
                    if (r < 64) v = bflo(Kd[(size_t)r * D + c]); else if (r < 128) v = bflo(Vd[(size_t)(r - 64) * D + c]);
                    else if (r < 192) v = bflo(Kd[((size_t)LP + r - 128) * D + c]); else if (r < 256) v = bflo(Vd[((size_t)LP + r - 192) * D + c]);
                    else if (r == 256 && c < 64) v = __builtin_bit_cast(float, ((const unsigned*)(F.ctl + CW_KMAX))[c]);
                    if (!(fabsf(v) < 1e30f)) v = 100.0f; }
                if (MK_DUMP == 3) { v = bflo(Od[(size_t)r * D + c]); if (!(fabsf(v) < 1e30f)) v = 100.0f; }
                F.out[(size_t)r * D + c] = v; }
        }
    }
#endif
#undef IN
#undef SEAM
}

extern "C" void kernel_launch(void* const* d_in, const int* in_sizes, int n_in, void* d_out, int out_size, void* d_ws, size_t ws_size, hipStream_t stream) {
    static int grid = 0;
    if (grid == 0) {
        if (n_in != 28 || out_size != NREAL * D || ws_size < WS_END) { fprintf(stderr, "kernel_launch: unexpected shapes (n_in %d, out %d, ws %zu); nothing launched\n", n_in, out_size, ws_size); grid = -1; return; }
        int dev = 0, cus = 0, per_cu = 0;
        if (hipGetDevice(&dev) != hipSuccess || hipDeviceGetAttribute(&cus, hipDeviceAttributeMultiprocessorCount, dev) != hipSuccess) { grid = -1; return; }
        if (hipFuncSetAttribute((const void*)mk_fwd, hipFuncAttributeMaxDynamicSharedMemorySize, LDS_BYTES) != hipSuccess) { fprintf(stderr, "kernel_launch: hipFuncSetAttribute failed\n"); grid = -1; return; }
        if (hipOccupancyMaxActiveBlocksPerMultiprocessor(&per_cu, (const void*)mk_fwd, NWAVES * 64, LDS_BYTES) != hipSuccess || per_cu < 1) { fprintf(stderr, "kernel_launch: occupancy query says %d\n", per_cu); }
        (void)hipGetLastError();
        grid = cus > 256 ? 256 : cus;
    }
    if (grid < 0) return;
    if (hipMemsetAsync((char*)d_ws + WS_CTL, 0, CTL_ZERO_BYTES, stream) != hipSuccess) return;
    Args a{};
    for (int i = 0; i < 28; ++i) a.in[i] = (const float*)d_in[i];
    a.out = (float*)d_out; a.ws = (unsigned char*)d_ws;
#ifdef MK_PROBE_SCHED
    { static const int sched[] = MK_PROBE_SCHED;
      for (unsigned k = 0; k < sizeof(sched) / sizeof(sched[0]); ++k) { a.ph_lo = sched[k]; a.ph_hi = sched[k] + 1; a.li = 0; a.pad = 0; hipLaunchKernelGGL(mk_fwd, dim3(grid), dim3(NWAVES * 64), LDS_BYTES, stream, a); }
      return; }
#endif
    constexpr int NL = MK_N_LAUNCHES;
#ifndef MK_STOP
#define MK_STOP N_PHASES
#endif
    for (int li = 0; li < NL && li < MK_STOP; ++li) {
        a.ph_lo = (NL == 1) ? 0 : li; a.ph_hi = (NL == 1) ? N_PHASES : li + 1; a.li = (NL == 1) ? 0 : 0; a.pad = 0;
        hipLaunchKernelGGL(mk_fwd, dim3(grid), dim3(NWAVES * 64), LDS_BYTES, stream, a);
    }
#ifdef MK_DUMP
    a.ph_lo = 17; a.ph_hi = 18; a.li = 0; hipLaunchKernelGGL(mk_fwd, dim3(grid), dim3(NWAVES * 64), LDS_BYTES, stream, a);
#endif
}
```

```cpp
#include <hip/hip_runtime.h>
#include <cstdio>
#include <cstdint>

#define MK_STR_(x) #x
#define MK_STR(x) MK_STR_(x)
#ifndef MK_ATT_PAD0
#define MK_ATT_PAD0 5
#endif
#ifndef MK_ATT_PAD1
#define MK_ATT_PAD1 9
#endif
#ifndef MK_ATT_PAD
#define MK_ATT_PAD 2
#endif
#ifndef MK_GEMM_PAD
#define MK_GEMM_PAD 8
#endif
#ifndef MK_N_LAUNCHES
#define MK_N_LAUNCHES 1
#endif

namespace pg8 {
#define PG8_LAS __attribute__((address_space(3)))
typedef unsigned short bf16_t;
typedef short bf16x8 __attribute__((ext_vector_type(8)));
typedef float f32x4 __attribute__((ext_vector_type(4)));
typedef unsigned u32x4 __attribute__((ext_vector_type(4)));
constexpr int BM = 256, BK = 64, HALF = 128, HTB = HALF * BK * 2  , STAGE_BYTES = 8 * HTB, NXCD = 8, WGM = 8;

__host__ __device__ __forceinline__ int lds_byte(int r, int c) { const int st = (r >> 4) * 2 + (c >> 5), rr = r & 15, cc = c & 31, ob = rr * 64 + cc * 2; return st * 1024 + (ob ^ (((ob >> 9) & 1) << 5)); }
__host__ __device__ __forceinline__ void stage_rc(int b, int& R, int& C) { const int st = b / 1024, sb = b % 1024, swz = sb ^ (((sb >> 9) & 1) << 5); R = (st >> 1) * 16 + swz / 64; C = (st & 1) * 32 + (swz % 64) / 2; }
__host__ __device__ __forceinline__ int perm32(int rho) { const int n = rho >> 4, i = rho & 15; return 8 * (i >> 2) + 4 * n + (i & 3); }

struct Unit { int pm, pn; const char* A; const char* B; };

__device__ __forceinline__ unsigned cvt_pk_bf16(float lo, float hi) { unsigned r; asm volatile("v_cvt_pk_bf16_f32 %0, %1, %2" : "=v"(r) : "v"(lo), "v"(hi)); return r; }

template <class Epi, class Sched, bool ALIGN_EPI = false, bool SP2 = false, bool GATHER = false>
__device__ __forceinline__ void gemm_phase(PG8_LAS unsigned char* lds, const int K, const Sched& S, const Epi& E, const PG8_LAS int* gtab = nullptr) {
    const int tid = threadIdx.x, wid = __builtin_amdgcn_readfirstlane(tid >> 6), lane = tid & 63, wr = wid >> 2, wc = wid & 3, fr = lane & 15, fq = lane >> 4;
    const int nt = K / BK;
    unsigned voffA[2], voffB[2]; int gR[2]; unsigned gC[2];
#pragma unroll
    for (int i = 0; i < 2; ++i) { int R, C; stage_rc(tid * 16 + i * 8192, R, C); const int Rb = Epi::PERM ? ((R & ~31) + perm32(R & 31)) : R;
        voffA[i] = (unsigned)(R * K + C) * 2u; voffB[i] = (unsigned)(Rb * K + C) * 2u; gR[i] = R; gC[i] = (unsigned)C * 2u; }
    const size_t kstep = (size_t)(BK * 2);
    const size_t hstep = (size_t)HALF * K * 2;
    unsigned cvo0[2], cvo1[2], nvo0[2], nvo1[2];
#define PG8_GVO(V0, V1, ui_) do { _Pragma("unroll") for (int _i = 0; _i < 2; ++_i) { \
        if constexpr (GATHER) { V0[_i] = (unsigned)gtab[(ui_) * 256 + gR[_i]] * (unsigned)(K * 2) + gC[_i]; V1[_i] = (unsigned)gtab[(ui_) * 256 + 128 + gR[_i]] * (unsigned)(K * 2) + gC[_i]; } \
        else { V0[_i] = voffA[_i]; V1[_i] = voffA[_i] + (unsigned)hstep; } } } while (0)
    const unsigned ldsw = (unsigned)wid * 1024u;
    const int aoff = lds_byte(wr * 64 + fr, fq * 8), boff = lds_byte(wc * 32 + fr, fq * 8);
#define PG8_SA(b, h) (((b) * 2 + (h)) * HTB)
#define PG8_SB(b, h) ((4 + (b) * 2 + (h)) * HTB)
#define PG8_STAGE(bufoff, gbase, voff) do { _Pragma("unroll") for (int _i = 0; _i < 2; ++_i) \
        __builtin_amdgcn_global_load_lds((const unsigned*)((const char*)(gbase) + (voff)[_i]), (PG8_LAS unsigned*)(lds + (bufoff) + ldsw + _i * 8192), 16, 0, 0); } while (0)
#define PG8_LDA(dst, b, h) do { _Pragma("unroll") for (int m = 0; m < 4; ++m) _Pragma("unroll") for (int k = 0; k < 2; ++k) dst[m][k] = *(const PG8_LAS bf16x8*)(lds + PG8_SA(b, h) + aoff + m * 2048 + k * 1024); } while (0)
#define PG8_LDB(dst, b, h) do { _Pragma("unroll") for (int n = 0; n < 2; ++n) _Pragma("unroll") for (int k = 0; k < 2; ++k) dst[n][k] = *(const PG8_LAS bf16x8*)(lds + PG8_SB(b, h) + boff + n * 2048 + k * 1024); } while (0)
#define PG8_MMA(ai, bj, At, Bt) do { __builtin_amdgcn_s_setprio(1); _Pragma("unroll") for (int m = 0; m < 4; ++m) _Pragma("unroll") for (int n = 0; n < 2; ++n) _Pragma("unroll") for (int k = 0; k < 2; ++k) \
        acc[ai][bj][m][n] = __builtin_amdgcn_mfma_f32_16x16x32_bf16(Bt[n][k], At[m][k], acc[ai][bj][m][n], 0, 0, 0); __builtin_amdgcn_s_setprio(0); } while (0)
#define PG8_WAIT_V(n) asm volatile("s_waitcnt vmcnt(" #n ")" ::: "memory")
#define PG8_WAIT_L(n) asm volatile("s_waitcnt lgkmcnt(" #n ")" ::: "memory")
#define PG8_BAR __builtin_amdgcn_s_barrier()
#define PG8_SCHED __builtin_amdgcn_sched_barrier(0)
    Unit cur, nxt; int ui = 0;
    if (!S.next(0, cur)) return;
    f32x4 acc[2][2][4][2];
#pragma unroll
    for (int a = 0; a < 2; ++a)
#pragma unroll
        for (int b = 0; b < 2; ++b)
#pragma unroll
            for (int m = 0; m < 4; ++m)
#pragma unroll
                for (int n = 0; n < 2; ++n) acc[a][b][m][n] = (f32x4){0.f, 0.f, 0.f, 0.f};
    bf16x8 At[4][2], B0[2][2], B1[2][2];
    const char* cA = cur.A; const char* cB = cur.B;
    PG8_GVO(cvo0, cvo1, 0);
    S.a_ready(cur);
    if constexpr (SP2) {
        PG8_STAGE(PG8_SB(0, 0), cB, voffB); PG8_STAGE(PG8_SB(0, 1), cB + hstep, voffB); PG8_STAGE(PG8_SA(0, 0), cA, cvo0); PG8_STAGE(PG8_SA(0, 1), cA, cvo1);
        if (wr == 1) PG8_BAR;
        PG8_WAIT_V(2); PG8_BAR;
        PG8_STAGE(PG8_SB(1, 0), cB + kstep, voffB); PG8_STAGE(PG8_SA(1, 0), cA + kstep, cvo0); PG8_STAGE(PG8_SB(1, 1), cB + hstep + kstep, voffB);
        PG8_WAIT_V(6); PG8_BAR;
    } else {
        PG8_STAGE(PG8_SB(0, 0), cB, voffB); PG8_STAGE(PG8_SA(0, 0), cA, cvo0); PG8_STAGE(PG8_SB(0, 1), cB + hstep, voffB); PG8_STAGE(PG8_SA(0, 1), cA, cvo1);
        if (wr == 1) PG8_BAR;
        PG8_WAIT_V(4); PG8_BAR;
        PG8_STAGE(PG8_SB(1, 0), cB + kstep, voffB); PG8_STAGE(PG8_SA(1, 0), cA + kstep, cvo0); PG8_STAGE(PG8_SB(1, 1), cB + hstep + kstep, voffB);
        PG8_WAIT_V(6); PG8_BAR;
    }
    for (;;) {
        const bool has_next = S.next(ui + 1, nxt);
        const char* nA = has_next ? nxt.A : cA; const char* nB = has_next ? nxt.B : cB;
        if (has_next) PG8_GVO(nvo0, nvo1, ui + 1); else { _Pragma("unroll") for (int _i = 0; _i < 2; ++_i) { nvo0[_i] = cvo0[_i]; nvo1[_i] = cvo1[_i]; } }
        asm volatile(".p2align 6\n\t.fill " MK_STR(MK_GEMM_PAD) ", 4, 0xBF800000" ::: "memory");
        for (int t = 0; t < nt; t += 2) {
            const bool last = (t == nt - 2);
            const char* a1 = cA + (size_t)(t + 1) * kstep;
            const char* a2 = last ? nA : cA + (size_t)(t + 2) * kstep; const char* b2 = last ? nB : cB + (size_t)(t + 2) * kstep;
            const char* a3 = a2 + kstep; const char* b3 = b2 + kstep;
            unsigned x0[2], x1[2];
            _Pragma("unroll") for (int _i = 0; _i < 2; ++_i) { x0[_i] = last ? nvo0[_i] : cvo0[_i]; x1[_i] = last ? nvo1[_i] : cvo1[_i]; }
            if (last && has_next) S.a_ready(nxt);
            if constexpr (SP2) {
            PG8_LDB(B0, 0, 0); PG8_LDB(B1, 0, 1); PG8_SCHED; PG8_LDA(At, 0, 0); PG8_STAGE(PG8_SA(1, 1), a1, cvo1);
            PG8_WAIT_V(8); PG8_WAIT_L(0); PG8_BAR; PG8_MMA(0, 0, At, B0); PG8_MMA(0, 1, At, B1); PG8_BAR; PG8_SCHED;
            PG8_LDA(At, 0, 1); PG8_STAGE(PG8_SB(0, 0), b2, voffB); PG8_STAGE(PG8_SB(0, 1), b2 + hstep, voffB); PG8_STAGE(PG8_SA(0, 0), a2, x0);
            PG8_WAIT_V(8); PG8_WAIT_L(0); PG8_BAR; PG8_MMA(1, 0, At, B0); PG8_MMA(1, 1, At, B1); PG8_BAR; PG8_SCHED;
            PG8_LDB(B0, 1, 0); PG8_LDB(B1, 1, 1); PG8_SCHED; PG8_LDA(At, 1, 0); PG8_STAGE(PG8_SA(0, 1), a2, x1);
            PG8_WAIT_V(8); PG8_WAIT_L(0); PG8_BAR; PG8_MMA(0, 0, At, B0); PG8_MMA(0, 1, At, B1); PG8_BAR; PG8_SCHED;
            PG8_LDA(At, 1, 1); PG8_STAGE(PG8_SB(1, 0), b3, voffB); PG8_STAGE(PG8_SB(1, 1), b3 + hstep, voffB); PG8_STAGE(PG8_SA(1, 0), a3, x0);
            PG8_WAIT_V(8); PG8_WAIT_L(0); PG8_BAR; PG8_MMA(1, 0, At, B0); PG8_MMA(1, 1, At, B1); PG8_BAR; PG8_SCHED;
            } else {
            PG8_LDB(B0, 0, 0); PG8_SCHED; PG8_LDA(At, 0, 0); PG8_STAGE(PG8_SA(1, 1), a1, cvo1);
            PG8_WAIT_L(8); PG8_BAR; PG8_WAIT_L(0); PG8_MMA(0, 0, At, B0); PG8_BAR; PG8_SCHED;
            PG8_LDB(B1, 0, 1); PG8_STAGE(PG8_SB(0, 0), b2, voffB);
            PG8_BAR; PG8_WAIT_L(0); PG8_MMA(0, 1, At, B1); PG8_BAR;
            PG8_LDA(At, 0, 1); PG8_STAGE(PG8_SA(0, 0), a2, x0);
            PG8_BAR; PG8_WAIT_L(0); PG8_MMA(1, 0, At, B0); PG8_BAR; PG8_SCHED;
            PG8_STAGE(PG8_SB(0, 1), b2 + hstep, voffB);
            PG8_WAIT_V(6); PG8_BAR; PG8_MMA(1, 1, At, B1); PG8_BAR;
            PG8_LDB(B0, 1, 0); PG8_SCHED; PG8_LDA(At, 1, 0); PG8_STAGE(PG8_SA(0, 1), a2, x1);
            PG8_WAIT_L(8); PG8_BAR; PG8_WAIT_L(0); PG8_MMA(0, 0, At, B0); PG8_BAR; PG8_SCHED;
            PG8_LDB(B1, 1, 1); PG8_STAGE(PG8_SB(1, 0), b3, voffB);
            PG8_BAR; PG8_WAIT_L(0); PG8_MMA(0, 1, At, B1); PG8_BAR;
            PG8_LDA(At, 1, 1); PG8_STAGE(PG8_SA(1, 0), a3, x0);
            PG8_BAR; PG8_WAIT_L(0); PG8_MMA(1, 0, At, B0); PG8_BAR; PG8_SCHED;
            PG8_STAGE(PG8_SB(1, 1), b3 + hstep, voffB);
            PG8_WAIT_V(6); PG8_BAR; PG8_MMA(1, 1, At, B1); PG8_BAR;
            }
        }
        if constexpr (ALIGN_EPI) { if (wr == 0) PG8_BAR; }
        if constexpr (!Epi::AFTER_DRAIN) { E(acc, cur, wr, wc, fr, fq); S.done(cur); }
        if (!has_next) break;
#pragma unroll
        for (int a = 0; a < 2; ++a)
#pragma unroll
            for (int b = 0; b < 2; ++b)
#pragma unroll
                for (int m = 0; m < 4; ++m)
#pragma unroll
                    for (int n = 0; n < 2; ++n) acc[a][b][m][n] = (f32x4){0.f, 0.f, 0.f, 0.f};
        cur = nxt; cA = nA; cB = nB; ++ui;
        _Pragma("unroll") for (int _i = 0; _i < 2; ++_i) { cvo0[_i] = nvo0[_i]; cvo1[_i] = nvo1[_i]; }
        if constexpr (ALIGN_EPI) { if (wr == 1) PG8_BAR; }
    }
    PG8_WAIT_V(0);
    if constexpr (!ALIGN_EPI) { if (wr == 0) PG8_BAR; }
    PG8_BAR;
    if constexpr (Epi::AFTER_DRAIN) { E.fused(acc, cur, wr, wc, fr, fq, lds, wid, lane); S.done(cur); }
#undef PG8_GVO
#undef PG8_SA
#undef PG8_SB
#undef PG8_STAGE
#undef PG8_LDA
#undef PG8_LDB
#undef PG8_MMA
#undef PG8_WAIT_V
#undef PG8_WAIT_L
#undef PG8_BAR
#undef PG8_SCHED
}
}

constexpr int NWAVES = 8;
constexpr int D = 1024, SEQ = 16384, NBATCH = 2, NMETA = 16;
constexpr int NREAL = NBATCH * SEQ;
constexpr int NTOK0 = NREAL + NMETA;
constexpr int MP = 33024;
constexpr int LP = 16448;
constexpr int NE = 16, DE = 512;
constexpr float ALPHA = 1.4142135623730951f, LN_EPS = 1e-5f;
constexpr float LAM_INIT = 0.35550906759096934f;
constexpr float C2 = 0.18033688011112042f;
constexpr float LOG2E = 1.4426950408889634f;

constexpr size_t MiB = 1u << 20, KiB = 1024;
constexpr size_t WS_CTL = 0, CTL_ZERO_BYTES = 1 * MiB;
constexpr size_t WS_ROPE = 1 * MiB;
constexpr size_t WS_METAH = 3 * MiB;
constexpr size_t WS_ROUTE_E = 3 * MiB + 64 * KiB;
constexpr size_t WS_ROUTE_W = 3 * MiB + 256 * KiB;
constexpr size_t WS_ROUTE_P = 3 * MiB + 576 * KiB;
constexpr size_t WS_WB = 4 * MiB;
constexpr size_t WS_BCNT = 4 * MiB + 128 * KiB;
constexpr size_t WS_TSTART = 4 * MiB + 192 * KiB;
constexpr size_t WS_WPW1 = 9 * MiB, WS_WPW2 = 13 * MiB, WS_WQKV = 15 * MiB, WS_WO = 21 * MiB;
constexpr size_t WS_W13 = 23 * MiB, WS_W2T = 55 * MiB;
constexpr size_t WS_W13B = 202 * MiB, WS_W2TB = 234 * MiB;
constexpr size_t WS_A = 72 * MiB;
constexpr size_t WS_R1 = 137 * MiB;
constexpr size_t WS_R2 = 274 * MiB;
constexpr size_t WS_R3 = 343 * MiB;
constexpr size_t WS_K = WS_R3 + 65 * MiB;
constexpr size_t WS_END = 480 * MiB;
constexpr int CW_KMAX = 1024;
constexpr int CW_BAR = 4096;
constexpr int CW_ROWIDX = 131072;
constexpr int GTAB_OFF = 132096;

constexpr int RING_OFF = 0, RING_BYTES = 131072;
constexpr int LDSCTL_OFF = RING_BYTES, MISC_OFF = LDSCTL_OFF + 320;
constexpr int LDS_BYTES = 147456;

#define GAS __attribute__((address_space(1)))
#define LAS __attribute__((address_space(3)))
typedef unsigned short bf16;
typedef unsigned v4u __attribute__((ext_vector_type(4)));
typedef unsigned v2u __attribute__((ext_vector_type(2)));
typedef float f32x4 __attribute__((ext_vector_type(4)));
typedef float f32x2 __attribute__((ext_vector_type(2)));
typedef float f32x16 __attribute__((ext_vector_type(16)));
typedef short bf16x8 __attribute__((ext_vector_type(8)));
typedef short s16x4 __attribute__((ext_vector_type(4)));
typedef GAS unsigned gu32;
#define RLX_AGENT __ATOMIC_RELAXED, __HIP_MEMORY_SCOPE_AGENT
#define LDS_WAIT() asm volatile("s_waitcnt lgkmcnt(0)" ::: "memory")
#define VM_WAIT() asm volatile("s_waitcnt vmcnt(0)" ::: "memory")
__device__ __forceinline__ unsigned f2bf(float f) { unsigned u = __builtin_bit_cast(unsigned, f); return (u + 0x7fffu + ((u >> 16) & 1u)) >> 16; }
typedef __bf16 bf16x2v __attribute__((ext_vector_type(2)));
__device__ __forceinline__ unsigned pk2(float lo, float hi) { f32x2 v = {lo, hi}; bf16x2v b = __builtin_convertvector(v, bf16x2v); return __builtin_bit_cast(unsigned, b); }
__device__ __forceinline__ float bflo(unsigned x) { return __builtin_bit_cast(float, x << 16); }
__device__ __forceinline__ float bfhi(unsigned x) { return __builtin_bit_cast(float, x & 0xffff0000u); }
__device__ __forceinline__ float fast_exp2(float x) { return __builtin_amdgcn_exp2f(x); }
__device__ __forceinline__ float fast_rcp(float x) { return __builtin_amdgcn_rcpf(x); }
__device__ __forceinline__ float sigmoidf_(float x) { return fast_rcp(1.0f + fast_exp2(-x * LOG2E)); }
template <int CTRL, int ROWMASK> __device__ __forceinline__ float dpp_f(float v) { return __builtin_bit_cast(float, __builtin_amdgcn_update_dpp(0, __builtin_bit_cast(int, v), CTRL, ROWMASK, 0xF, false)); }
__device__ __forceinline__ float wave_sum(float v) {
    v += dpp_f<0x128, 0xF>(v); v += dpp_f<0x124, 0xF>(v); v += dpp_f<0x122, 0xF>(v); v += dpp_f<0x121, 0xF>(v);
    v += dpp_f<0x142, 0xA>(v);
    v += dpp_f<0x143, 0xC>(v);
    return __builtin_bit_cast(float, __builtin_amdgcn_readlane(__builtin_bit_cast(int, v), 63));
}

#define XB_TMO      128
#define XB_XCNT(j)  (256  + 64 * (j))
#define XB_XSUB(j)  (1280 + 64 * (j))
#define XB_XGEN(j)  (2304 + 64 * (j))
#define XB_TOP      3328
#define XB_TOPGEN   3392
#define XCD_BAR_WORDS 3456
#define XB_SPIN_CAP (1u << 20)

__device__ __forceinline__ unsigned xb_ld(unsigned* p)              { return __hip_atomic_load(p, __ATOMIC_RELAXED, __HIP_MEMORY_SCOPE_AGENT); }
__device__ __forceinline__ unsigned xb_add(unsigned* p, unsigned v) { return __hip_atomic_fetch_add(p, v, __ATOMIC_RELAXED, __HIP_MEMORY_SCOPE_AGENT); }
__device__ __forceinline__ unsigned xb_xcc_id() { return (unsigned)__builtin_amdgcn_s_getreg((3 << 11) | 20) & 0xFu; }
#define XB_SPIN(cond, bar) do { unsigned _sp = 0; while (cond) { __builtin_amdgcn_s_sleep(1); \
    if ((++_sp & 255u) == 0u) { if (xb_ld(&(bar)[XB_TMO])) break; if (_sp > XB_SPIN_CAP) { atomicAdd(&(bar)[XB_TMO], 1u); break; } } } } while (0)

struct XcdBarrier {
    unsigned* bar; unsigned x;
    volatile LAS unsigned* st;
};

__device__ __forceinline__ XcdBarrier xcd_barrier_post(unsigned* bar, volatile LAS unsigned* st) {
    XcdBarrier b; b.bar = bar; b.x = xb_xcc_id(); b.st = st;
    if (threadIdx.x == 0) (void)xb_add(&bar[XB_XCNT(b.x)], 1u);
    return b;
}
__device__ __forceinline__ void xcd_barrier_complete(unsigned* bar, unsigned x, unsigned& nloc, unsigned& nx) {
    const unsigned G = gridDim.x * gridDim.y * gridDim.z;
    unsigned sum, cnt, mine, sp = 0u;
    for (;;) {
        sum = 0u; cnt = 0u; mine = 0u;
#pragma unroll
        for (unsigned j = 0; j < 16; ++j) { const unsigned c = xb_ld(&bar[XB_XCNT(j)]); sum += c; cnt += (c > 0u) ? 1u : 0u; mine = (j == x) ? c : mine; }
        if (sum == G) break;
        __builtin_amdgcn_s_sleep(1);
        if ((++sp & 255u) == 0u) { if (xb_ld(&bar[XB_TMO])) break; if (sp > XB_SPIN_CAP) { atomicAdd(&bar[XB_TMO], 1u); break; } }
    }
    nloc = mine > 0u ? mine : 1u; nx = cnt > 0u ? cnt : 1u;
}

__device__ __forceinline__ void xcd_barrier(const XcdBarrier& b) {
    asm volatile("s_waitcnt vmcnt(0)" ::: "memory");
    __syncthreads();
    if (threadIdx.x == 0) {
        unsigned* bar = b.bar;
        __builtin_amdgcn_s_waitcnt(0);
        unsigned nloc = b.st[0], nx = b.st[1];
        if (nloc == 0u) { xcd_barrier_complete(bar, b.x, nloc, nx); b.st[0] = nloc; b.st[1] = nx; }
        const unsigned old = xb_add(&bar[XB_XSUB(b.x)], 1u);
        const unsigned gen = old / nloc;
        if (old + 1u == (gen + 1u) * nloc) {
            __builtin_amdgcn_fence(__ATOMIC_RELEASE, "agent");
            asm volatile("s_waitcnt vmcnt(0)" ::: "memory");
            const unsigned og = xb_add(&bar[XB_TOP], 1u);
            const unsigned tg = og / nx;
            if (og + 1u == (tg + 1u) * nx) xb_add(&bar[XB_TOPGEN], 1u);
            else XB_SPIN(xb_ld(&bar[XB_TOPGEN]) == tg, bar);
            __builtin_amdgcn_fence(__ATOMIC_ACQUIRE, "agent");
            xb_add(&bar[XB_XGEN(b.x)], 1u);
            asm volatile("s_waitcnt vmcnt(0)" ::: "memory");
        } else {
            XB_SPIN(xb_ld(&bar[XB_XGEN(b.x)]) == gen, bar);
            __builtin_amdgcn_fence(__ATOMIC_ACQUIRE, "agent");
            asm volatile("s_waitcnt vmcnt(0)" ::: "memory");
        }
    }
    __syncthreads();
}

struct Frame {
    LAS unsigned char* lds;
    volatile LAS unsigned* MISC;
    gu32* ctl;
    unsigned char* ws;
    int tid, lane, wave;
    int vcu, G;
    const float* in[28];
    float* out;
};
__device__ __forceinline__ float* hrow(const Frame& F, int r) { return r < NREAL ? F.out + (size_t)r * D : (float*)(F.ws + WS_METAH) + (size_t)(r - NREAL) * D; }
__device__ __forceinline__ const float* h0row(const Frame& F, int r) { return r < NREAL ? F.in[0] + (size_t)r * D : F.in[1] + (size_t)(r - NREAL) * D; }

struct DenseOrder {
    const char* A; const char* Bt; size_t tstep; int nM, nN, nwg, G, c;
    __device__ __forceinline__ void init(const void* A_, const void* Bt_, int K, int nM_, int nN_, int G_, int c_) {
        A = (const char*)A_; Bt = (const char*)Bt_; tstep = (size_t)256 * K * 2; nM = nM_; nN = nN_; nwg = nM * nN; G = G_; c = c_; }
    __device__ __forceinline__ bool map(int i, int& pm, int& pn) const {
        const long L = (long)i * G + c; if (L >= nwg) return false;
        int wgid = (int)L; { const int q = nwg / 8, r = nwg % 8, xcd = wgid % 8, off = wgid / 8; wgid = (xcd < r ? xcd * (q + 1) : r * (q + 1) + (xcd - r) * q) + off; }
        const int nig = 8 * nN, gid = wgid / nig, fm = gid * 8, gsz = (nM - fm) < 8 ? (nM - fm) : 8;
        pm = fm + ((wgid % nig) % gsz); pn = (wgid % nig) / gsz; return true;
    }
    __device__ __forceinline__ bool next(int i, pg8::Unit& u) const {
        if (!map(i, u.pm, u.pn)) return false;
        u.A = A + (size_t)u.pm * tstep; u.B = Bt + (size_t)u.pn * tstep; return true; }
    __device__ __forceinline__ void a_ready(const pg8::Unit&) const {}
    __device__ __forceinline__ void done(const pg8::Unit&) const {}
};
struct MoeOrder {
    DenseOrder d; size_t estep; int ts[17]; bool gather;
    __device__ __forceinline__ void init(const void* A_, const void* Bt_, int K, int nN_, size_t estep_, const int* tstart, int G_, int c_) {
#pragma unroll
        for (int e = 0; e < 17; ++e) ts[e] = __builtin_amdgcn_readfirstlane(tstart[e]);
        d.init(A_, Bt_, K, ts[16], nN_, G_, c_); estep = estep_; gather = false; }
    __device__ __forceinline__ bool next(int i, pg8::Unit& u) const {
        if (!d.map(i, u.pm, u.pn)) return false;
        int e = 0;
#pragma unroll
        for (int k = 1; k < 16; ++k) e += (u.pm >= ts[k]) ? 1 : 0;
        u.A = gather ? d.A : d.A + (size_t)u.pm * d.tstep; u.B = d.Bt + (size_t)e * estep + (size_t)u.pn * d.tstep; return true; }
    __device__ __forceinline__ void a_ready(const pg8::Unit&) const {}
    __device__ __forceinline__ void done(const pg8::Unit&) const {}
};

using pg8::Unit;
struct EpiGLU {
    static constexpr bool PERM = true, AFTER_DRAIN = false;
    bf16* U; const float* bias;
    __device__ __forceinline__ void operator()(const f32x4 (&acc)[2][2][4][2], const Unit& u, int wr, int wc, int fr, int fq) const {
        const int row0 = u.pm * 256 + wr * 64 + fr, oc = u.pn * 128 + wc * 32 + 8 * fq;
        f32x4 ba[2], bg[2];
#pragma unroll
        for (int n = 0; n < 2; ++n) { ba[n] = *(const f32x4*)(bias + oc + 4 * n); bg[n] = *(const f32x4*)(bias + D + oc + 4 * n); }
#pragma unroll
        for (int ai = 0; ai < 2; ++ai)
#pragma unroll
            for (int m = 0; m < 4; ++m) {
                float o[8];
#pragma unroll
                for (int n = 0; n < 2; ++n)
#pragma unroll
                    for (int i = 0; i < 4; ++i) { const float a = acc[ai][0][m][n][i] + ba[n][i], g = acc[ai][1][m][n][i] + bg[n][i]; o[4 * n + i] = a * sigmoidf_(g); }
                v4u w; w.x = pk2(o[0], o[1]); w.y = pk2(o[2], o[3]); w.z = pk2(o[4], o[5]); w.w = pk2(o[6], o[7]);
                *(v4u*)(U + (size_t)(row0 + ai * 128 + m * 16) * D + oc) = w;
            }
    }
};
struct EpiSwiGLU {
    static constexpr bool PERM = true, AFTER_DRAIN = false;
    bf16* H;
    __device__ __forceinline__ void operator()(const f32x4 (&acc)[2][2][4][2], const Unit& u, int wr, int wc, int fr, int fq) const {
        const int row0 = u.pm * 256 + wr * 64 + fr, oc = u.pn * 128 + wc * 32 + 8 * fq;
#pragma unroll
        for (int ai = 0; ai < 2; ++ai)
#pragma unroll
            for (int m = 0; m < 4; ++m) {
                float o[8];
#pragma unroll
                for (int n = 0; n < 2; ++n)
#pragma unroll
                    for (int i = 0; i < 4; ++i) { const float a = acc[ai][0][m][n][i], g = acc[ai][1][m][n][i]; o[4 * n + i] = a * sigmoidf_(a) * g; }
                v4u w; w.x = pk2(o[0], o[1]); w.y = pk2(o[2], o[3]); w.z = pk2(o[4], o[5]); w.w = pk2(o[6], o[7]);
                *(v4u*)(H + (size_t)(row0 + ai * 128 + m * 16) * DE + oc) = w;
            }
    }
};
struct EpiBf16 {
    static constexpr bool PERM = true, AFTER_DRAIN = false;
    bf16* O; const float* bias;
    __device__ __forceinline__ void operator()(const f32x4 (&acc)[2][2][4][2], const Unit& u, int wr, int wc, int fr, int fq) const {
        const int row0 = u.pm * 256 + wr * 64 + fr, oc = u.pn * 256 + wc * 32 + 8 * fq;
        f32x4 bv[2][2];
#pragma unroll
        for (int bj = 0; bj < 2; ++bj)
#pragma unroll
            for (int n = 0; n < 2; ++n) bv[bj][n] = bias ? *(const f32x4*)(bias + oc + bj * 128 + 4 * n) : (f32x4){0.f, 0.f, 0.f, 0.f};
#pragma unroll
        for (int ai = 0; ai < 2; ++ai)
#pragma unroll
            for (int m = 0; m < 4; ++m)
#pragma unroll
                for (int bj = 0; bj < 2; ++bj) {
                    const f32x4 v0 = acc[ai][bj][m][0] + bv[bj][0], v1 = acc[ai][bj][m][1] + bv[bj][1];
                    v4u w; w.x = pk2(v0[0], v0[1]); w.y = pk2(v0[2], v0[3]); w.z = pk2(v1[0], v1[1]); w.w = pk2(v1[2], v1[3]);
                    *(v4u*)(O + (size_t)(row0 + ai * 128 + m * 16) * D + oc + bj * 128) = w;
                }
    }
};
template <bool LAYER0> struct EpiResF32 {
    static constexpr bool PERM = false, AFTER_DRAIN = false;
    float* Y; const float* bias; const float* hreal; const float* hmeta; int nvalid;
    __device__ __forceinline__ void operator()(const f32x4 (&acc)[2][2][4][2], const Unit& u, int wr, int wc, int fr, int fq) const {
        const int row0 = u.pm * 256 + wr * 64 + fr, c0 = u.pn * 256 + wc * 32 + 4 * fq;
        f32x4 bv[2][2];
#pragma unroll
        for (int bj = 0; bj < 2; ++bj)
#pragma unroll
            for (int n = 0; n < 2; ++n) bv[bj][n] = bias ? *(const f32x4*)(bias + c0 + bj * 128 + n * 16) : (f32x4){0.f, 0.f, 0.f, 0.f};
#pragma unroll
        for (int ai = 0; ai < 2; ++ai)
#pragma unroll
            for (int m = 0; m < 4; ++m) {
                const int r = row0 + ai * 128 + m * 16;
                if (r < nvalid) {
                    const float* hp = (r < NREAL ? hreal + (size_t)r * D : hmeta + (size_t)(r - NREAL) * D) + c0;
                    float* yp = Y + (size_t)r * D + c0;
#pragma unroll
                    for (int bj = 0; bj < 2; ++bj)
#pragma unroll
                        for (int n = 0; n < 2; ++n) { const f32x4 h = *(const f32x4*)(hp + bj * 128 + n * 16); *(f32x4*)(yp + bj * 128 + n * 16) = acc[ai][bj][m][n] + bv[bj][n] + ALPHA * h; }
                }
            }
    }
};
struct EpiQKV {
    static constexpr bool PERM = true, AFTER_DRAIN = false;
    bf16* Q; bf16* Kb; bf16* Vb; const f32x4* rope; unsigned* kmax;
    __device__ __forceinline__ void operator()(const f32x4 (&acc)[2][2][4][2], const Unit& u, int wr, int wc, int fr, int fq) const {
        const int kind = u.pn >> 2;
        const int cb = (u.pn & 3) * 256 + wc * 32 + 8 * fq;
        const bool meta = (u.pm == 128);
        const int b = u.pm >> 6;
        const bool dorope = (kind != 1) && ((wc & 1) == 0) && (fq < 2);
        float nmax[2] = {0.f, 0.f};
#pragma unroll
        for (int ai = 0; ai < 2; ++ai)
#pragma unroll
            for (int m = 0; m < 4; ++m) {
                const int r = u.pm * 256 + ai * 128 + wr * 64 + m * 16 + fr;
                const bool valid = !meta || (r - NREAL) < NMETA;
                int pos = meta ? (r - NREAL) : NMETA + (r & (SEQ - 1));
                if (!valid) pos = 0;
                f32x4 v[2][2];
#pragma unroll
                for (int bj = 0; bj < 2; ++bj)
#pragma unroll
                    for (int n = 0; n < 2; ++n) v[bj][n] = acc[ai][bj][m][n];
                if (dorope) {
                    const f32x4 cs0 = rope[(size_t)pos * 4 + 2 * fq], cs1 = rope[(size_t)pos * 4 + 2 * fq + 1];
                    const float cc[4] = {cs0[0], cs0[2], cs1[0], cs1[2]}, ss[4] = {cs0[1], cs0[3], cs1[1], cs1[3]};
#pragma unroll
                    for (int bj = 0; bj < 2; ++bj)
#pragma unroll
                        for (int i = 0; i < 4; ++i) { const float t1 = v[bj][0][i], t2 = v[bj][1][i]; v[bj][0][i] = t1 * cc[i] - t2 * ss[i]; v[bj][1][i] = t1 * ss[i] + t2 * cc[i]; }
                }
                if (kind == 0) {
#pragma unroll
                    for (int bj = 0; bj < 2; ++bj) {
                        float ps = 0.f;
#pragma unroll
                        for (int n = 0; n < 2; ++n)
#pragma unroll
                            for (int i = 0; i < 4; ++i) ps += v[bj][n][i] * v[bj][n][i];
                        ps += __shfl_xor(ps, 16); ps += __shfl_xor(ps, 32);
                        if (valid) nmax[bj] = fmaxf(nmax[bj], ps);
                    }
                }
                const float sc = (kind == 2) ? C2 : 1.0f;
#pragma unroll
                for (int bj = 0; bj < 2; ++bj) {
                    const f32x4 v0 = v[bj][0] * sc, v1 = v[bj][1] * sc;
                    v4u w; w.x = pk2(v0[0], v0[1]); w.y = pk2(v0[2], v0[3]); w.z = pk2(v1[0], v1[1]); w.w = pk2(v1[2], v1[3]);
                    const int col = cb + bj * 128;
                    if (kind == 2) { if (!meta) *(v4u*)(Q + (size_t)r * D + col) = w; }
                    else {
                        bf16* dst = (kind == 0) ? Kb : Vb;
                        if (!meta) *(v4u*)(dst + ((size_t)b * LP + 64 + (r & (SEQ - 1))) * D + col) = w;
                        else if (valid) { const int pp = 48 + (r - NREAL); *(v4u*)(dst + (size_t)pp * D + col) = w; *(v4u*)(dst + ((size_t)LP + pp) * D + col) = w; }
                    }
                }
            }
        if (kind == 0) {
#pragma unroll
            for (int bj = 0; bj < 2; ++bj) {
                float mx = nmax[bj];
                mx = fmaxf(mx, __shfl_xor(mx, 1)); mx = fmaxf(mx, __shfl_xor(mx, 2)); mx = fmaxf(mx, __shfl_xor(mx, 4)); mx = fmaxf(mx, __shfl_xor(mx, 8));
                if ((threadIdx.x & 63) == 0) {
                    const int hc = ((u.pn & 3) * 256 + bj * 128 + wc * 32) >> 6, hf = wc & 1;
                    const unsigned bits = __builtin_bit_cast(unsigned, mx);
                    if (!meta) atomicMax(kmax + (b * 16 + hc) * 2 + hf, bits);
                    else { atomicMax(kmax + (0 * 16 + hc) * 2 + hf, bits); atomicMax(kmax + (1 * 16 + hc) * 2 + hf, bits); }
                }
            }
        }
    }
};

__device__ __forceinline__ f32x4 mini_tile(const bf16* A16, const bf16* Bt, int brow0, int K, int lane) {
    const bf16* ap = A16 + (size_t)(lane & 15) * K + 8 * (lane >> 4);
    const bf16* bp = Bt + (size_t)(brow0 + (lane & 15)) * K + 8 * (lane >> 4);
    f32x4 acc = {0.f, 0.f, 0.f, 0.f};
#pragma unroll 8
    for (int k0 = 0; k0 < K; k0 += 32) { const bf16x8 a = *(const bf16x8*)(ap + k0), b = *(const bf16x8*)(bp + k0); acc = __builtin_amdgcn_mfma_f32_16x16x32_bf16(a, b, acc, 0, 0, 0); }
    return acc;
}
__device__ __forceinline__ void mini_glu(Frame& F) {
    const int tix = blockIdx.x * NWAVES + F.wave; if (tix >= 64) return;
    const bf16* A16 = (const bf16*)(F.ws + WS_A) + (size_t)NREAL * D; const bf16* Bt = (const bf16*)(F.ws + WS_WPW1); bf16* U = (bf16*)(F.ws + WS_R2);
    const int c = 16 * tix + (F.lane & 15), ra = 256 * (c >> 7) + (c & 127) - (F.lane & 15);
    const f32x4 aa = mini_tile(A16, Bt, ra, D, F.lane), ag = mini_tile(A16, Bt, ra + 128, D, F.lane);
    const float ba = F.in[3][c], bg = F.in[3][D + c];
#pragma unroll
    for (int i = 0; i < 4; ++i) { const int row = NREAL + 4 * (F.lane >> 4) + i; U[(size_t)row * D + c] = (bf16)f2bf((aa[i] + ba) * sigmoidf_(ag[i] + bg)); }
}
__device__ __forceinline__ void mini_pw2(Frame& F) {
    const int tix = blockIdx.x * NWAVES + F.wave; if (tix >= 64) return;
    const bf16* A16 = (const bf16*)(F.ws + WS_R3) + (size_t)NREAL * D; const bf16* Bt = (const bf16*)(F.ws + WS_WPW2); bf16* Y = (bf16*)(F.ws + WS_R1);
    const int c = 16 * tix + (F.lane & 15);
    const f32x4 a = mini_tile(A16, Bt, 16 * tix, D, F.lane);
    const float bb = F.in[9][c];
#pragma unroll
    for (int i = 0; i < 4; ++i) { const int j = 4 * (F.lane >> 4) + i; Y[(size_t)(NREAL + j) * D + c] = (bf16)f2bf(a[i] + bb); }
}
__device__ __forceinline__ void mini_kv(Frame& F) {
    const int tix = blockIdx.x * NWAVES + F.wave; if (tix >= 128) return;
    const bf16* A16 = (const bf16*)(F.ws + WS_A) + (size_t)NREAL * D; const bf16* Bt = (const bf16*)(F.ws + WS_WQKV);
    const int isv = tix >> 6, t = tix & 63, p = F.lane & 15, c = 16 * t + p;
    f32x4 a = mini_tile(A16, Bt, isv * D + 16 * t, D, F.lane);
    bf16* dst = (bf16*)(F.ws + (isv ? WS_R1 : WS_K));
    if (!isv) {
        if ((t & 3) == 0) {
            const f32x2* rope = (const f32x2*)(F.ws + WS_ROPE);
            const int jj = (p & 3) + 4 * (p >> 3);
#pragma unroll
            for (int i = 0; i < 4; ++i) { const int pos = 4 * (F.lane >> 4) + i; const f32x2 cs = rope[pos * 8 + jj];
                const float own = a[i], oth = __shfl_xor(own, 4);
                a[i] = (p & 4) ? (oth * cs.y + own * cs.x) : (own * cs.x - oth * cs.y); }
        }
        float mx = 0.f;
#pragma unroll
        for (int i = 0; i < 4; ++i) { float ps = a[i] * a[i]; ps += __shfl_xor(ps, 1); ps += __shfl_xor(ps, 2); ps += __shfl_xor(ps, 4); ps += __shfl_xor(ps, 8); mx = fmaxf(mx, ps); }
        mx = fmaxf(mx, __shfl_xor(mx, 16)); mx = fmaxf(mx, __shfl_xor(mx, 32));
        if (F.lane == 0) {
            const unsigned bits = __builtin_bit_cast(unsigned, 2.0f * mx); unsigned* kmax = (unsigned*)(F.ctl + CW_KMAX);
            const int hc = t >> 2, hf = (t >> 1) & 1;
            atomicMax(kmax + (0 * 16 + hc) * 2 + hf, bits); atomicMax(kmax + (1 * 16 + hc) * 2 + hf, bits);
        }
    }
#pragma unroll
    for (int i = 0; i < 4; ++i) { const int pp = 48 + 4 * (F.lane >> 4) + i; const bf16 v = (bf16)f2bf(a[i]); dst[(size_t)pp * D + c] = v; dst[((size_t)LP + pp) * D + c] = v; }
}

template <class RowMap>
__device__ __forceinline__ void transpose_item(const float* W, int K, int N, bf16* WT, const RowMap& rm, LAS float* scr, int item, int lane) {
    const int nblk = N / 32, kb = item / nblk, nb = item % nblk, k0 = 64 * kb, n0 = 32 * nb;
    float tv[32];
#pragma unroll
    for (int i = 0; i < 32; ++i) tv[i] = W[(size_t)(k0 + 2 * i + (lane >> 5)) * N + n0 + (lane & 31)];
#pragma unroll
    for (int i = 0; i < 32; ++i) scr[(2 * i + (lane >> 5)) * 33 + (lane & 31)] = tv[i];
    LDS_WAIT(); asm volatile("" ::: "memory");
    const int c = lane & 7;
#pragma unroll
    for (int j = 0; j < 4; ++j) { const int n = (lane >> 3) + 8 * j; const LAS float* s = scr + (8 * c) * 33 + n;
        v4u o; o.x = pk2(s[0 * 33], s[1 * 33]); o.y = pk2(s[2 * 33], s[3 * 33]); o.z = pk2(s[4 * 33], s[5 * 33]); o.w = pk2(s[6 * 33], s[7 * 33]);
        *(GAS v4u*)(WT + (size_t)rm(n0 + n) * K + k0 + 8 * c) = o; }
    LDS_WAIT(); asm volatile("" ::: "memory");
}
struct RmId { int off; __device__ __forceinline__ int operator()(int n) const { return off + n; } };
struct RmGlu { int half, part; __device__ __forceinline__ int operator()(int n) const { return 256 * (n >> 7) + 128 * part + (n & 127); } };
struct RmRope { int off; __device__ __forceinline__ int operator()(int n) const { const int dd = n & 63; int p = dd; if (dd >= 4 && dd < 8) p = dd + 4; else if (dd >= 8 && dd < 12) p = dd - 4; return off + (n & ~63) + p; } };

__device__ __forceinline__ void moe_weights_convert(Frame& F, int layer, int gw, int NGW) {
    LAS float* scr = (LAS float*)(F.lds + RING_OFF + F.wave * 16384);
    bf16* W13 = (bf16*)(F.ws + (layer ? WS_W13B : WS_W13)); bf16* W2T = (bf16*)(F.ws + (layer ? WS_W2TB : WS_W2T));
    constexpr int I13 = (D / 64) * (DE / 32), I2 = (DE / 64) * (D / 32);
    for (int it = gw; it < NE * (2 * I13 + I2); it += NGW) {
        const int e = it / (2 * I13 + I2); int r = it % (2 * I13 + I2);
        const size_t woff = ((size_t)layer * NE + e) * (size_t)D * DE;
        if (r < I13) { transpose_item(F.in[25] + woff, D, DE, W13 + (size_t)e * D * D, RmGlu{0, 0}, scr, r, F.lane); continue; } r -= I13;
        if (r < I13) { transpose_item(F.in[26] + woff, D, DE, W13 + (size_t)e * D * D, RmGlu{0, 1}, scr, r, F.lane); continue; } r -= I13;
        transpose_item(F.in[27] + woff, DE, D, W2T + (size_t)e * D * DE, RmId{0}, scr, r, F.lane);
    }
}
__device__ __forceinline__ void sincos_acc(float af, float& c, float& s) {
    const double a = (double)af;
    const double q = __builtin_rint(a * 0.63661977236758134308);
    const double y = (a - q * 1.57079632679489655800) - q * 6.123233995736766036e-17;
    const double y2 = y * y;
    double sp = 1.0 / 1307674368000.0; sp = sp * y2 - 1.0 / 6227020800.0; sp = sp * y2 + 1.0 / 39916800.0; sp = sp * y2 - 1.0 / 362880.0; sp = sp * y2 + 1.0 / 5040.0; sp = sp * y2 - 1.0 / 120.0; sp = sp * y2 + 1.0 / 6.0;
    const double sy = y - y * y2 * sp;
    double cp = 1.0 / 87178291200.0; cp = cp * y2 - 1.0 / 479001600.0; cp = cp * y2 + 1.0 / 3628800.0; cp = cp * y2 - 1.0 / 40320.0; cp = cp * y2 + 1.0 / 720.0; cp = cp * y2 - 1.0 / 24.0; cp = cp * y2 + 0.5;
    const double cy = 1.0 - y2 * cp;
    const int qi = ((int)q) & 3;
    const double sv = (qi == 0) ? sy : (qi == 1) ? cy : (qi == 2) ? -sy : -cy;
    const double cv = (qi == 0) ? cy : (qi == 1) ? -sy : (qi == 2) ? -cy : sy;
    c = (float)cv; s = (float)sv;
}
__device__ __forceinline__ void p0_prologue(Frame& F) {
    LAS float* scr = (LAS float*)(F.lds + RING_OFF + F.wave * 16384);
    const int gw = blockIdx.x * NWAVES + F.wave, NGW = F.G * NWAVES;
    bf16* Wpw1 = (bf16*)(F.ws + WS_WPW1); bf16* Wpw2 = (bf16*)(F.ws + WS_WPW2); bf16* Wqkv = (bf16*)(F.ws + WS_WQKV); bf16* Wo = (bf16*)(F.ws + WS_WO);
    constexpr int I_PW1 = (D / 64) * (2 * D / 32), I_SQ = (D / 64) * (D / 32);
    constexpr int NITEMS = I_PW1 + 5 * I_SQ;
    for (int it = gw; it < NITEMS; it += NGW) {
        int r = it;
        if (r < I_PW1) {
            const int nblk = 2 * D / 32, nb = r % nblk; const int part = (nb * 32) >= D ? 1 : 0;
            const int kb = r / nblk, nbl = nb - part * (D / 32);
            transpose_item(F.in[2] + part * D, D, 2 * D, Wpw1, RmGlu{0, part}, scr, kb * nblk + nbl, F.lane);
            continue; }
        r -= I_PW1;
        if (r < I_SQ) { transpose_item(F.in[8], D, D, Wpw2, RmId{0}, scr, r, F.lane); continue; } r -= I_SQ;
        if (r < I_SQ) { transpose_item(F.in[10], D, D, Wqkv, RmRope{0}, scr, r, F.lane); continue; } r -= I_SQ;
        if (r < I_SQ) { transpose_item(F.in[11], D, D, Wqkv, RmId{D}, scr, r, F.lane); continue; } r -= I_SQ;
        if (r < I_SQ) { transpose_item(F.in[12], D, D, Wqkv, RmRope{2 * D}, scr, r, F.lane); continue; } r -= I_SQ;
        transpose_item(F.in[18], D, D, Wo, RmId{0}, scr, r, F.lane);
    }
    moe_weights_convert(F, 0, gw, NGW);
    bf16* A = (bf16*)(F.ws + WS_A);
    for (int m = gw; m < MP; m += NGW) {
        GAS unsigned long long* o8 = (GAS unsigned long long*)(A + (size_t)m * D) + F.lane;
        if (m < NTOK0) {
            const GAS f32x4* xr = (const GAS f32x4*)h0row(F, m) + F.lane;
#pragma unroll
            for (int j = 0; j < 4; ++j) { const f32x4 v = xr[64 * j]; o8[64 * j] = (unsigned long long)pk2(v.x, v.y) | ((unsigned long long)pk2(v.z, v.w) << 32); }
        } else {
#pragma unroll
            for (int j = 0; j < 4; ++j) o8[64 * j] = 0ull;
        }
    }
    {
        const float inv[8] = {1.0f, 0.1939227432012558f, 0.03760603070259094f, 0.007292664609849453f, 0.0014142135623842478f, 0.00027424818836152554f, 5.318296098266728e-05f, 1.0313386155758053e-05f};
        f32x2* rope = (f32x2*)(F.ws + WS_ROPE);
        for (int idx = blockIdx.x * 512 + F.tid; idx < (SEQ + NMETA) * 8; idx += F.G * 512) {
            const int pos = idx >> 3, j = idx & 7;
            float iv = inv[0];
#pragma unroll
            for (int k = 1; k < 8; ++k) iv = (j == k) ? inv[k] : iv;
            const float ang = (float)pos * iv; float c, s; sincos_acc(ang, c, s);
            rope[idx] = (f32x2){c, s};
        }
    }
}

__device__ __forceinline__ unsigned conv_rowload(const bf16* U, int b, int ch, int pp) {
    const int pc = pp < 0 ? 0 : pp, row = pc < NMETA ? NREAL + pc : b * SEQ + pc - NMETA;
    const unsigned v = *(const unsigned*)(U + (size_t)row * D + ch);
    return pp < 0 ? 0u : v;
}
__device__ __forceinline__ void conv_phase(Frame& F) {
    const bf16* U = (const bf16*)(F.ws + WS_R2); bf16* C = (bf16*)(F.ws + WS_R3);
    const int tid = F.tid, ch = 2 * tid;
    float w0[31], w1[31];
#pragma unroll
    for (int k = 0; k < 31; ++k) { const f32x2 v = *(const f32x2*)(F.in[4] + (size_t)k * D + ch); w0[k] = v.x; w1[k] = v.y; }
    const f32x2 bdw = *(const f32x2*)(F.in[5] + ch), lg = *(const f32x2*)(F.in[6] + ch), lb = *(const f32x2*)(F.in[7] + ch);
    LAS float* red = (LAS float*)(F.lds + RING_OFF);
    LAS float* fin = (LAS float*)(F.lds + RING_OFF + 2048);
    const bool b5 = (F.lane & 32) != 0, b4 = (F.lane & 16) != 0, b3 = (F.lane & 8) != 0, b2 = (F.lane & 4) != 0, b1 = (F.lane & 2) != 0;
    for (int u = blockIdx.x; u < 257; u += F.G) {
        const bool mu = (u == 256);
        const int b = mu ? 0 : (u >> 7), posbase = mu ? 0 : NMETA + (u & 127) * 128, nblk = mu ? 1 : 8;
        unsigned in[46], nx[16];
#define CONV_ROWLOAD(pp) conv_rowload(U, b, ch, (pp))
#pragma unroll
        for (int i = 0; i < 30; ++i) in[i] = CONV_ROWLOAD(posbase - 30 + i);
#pragma unroll
        for (int i = 0; i < 16; ++i) nx[i] = CONV_ROWLOAD(posbase + i);
        for (int kb = 0; kb < nblk; ++kb) {
            const int p0 = posbase + 16 * kb;
#pragma unroll
            for (int i = 0; i < 16; ++i) in[30 + i] = nx[i];
            if (kb + 1 < nblk) {
#pragma unroll
                for (int i = 0; i < 16; ++i) nx[i] = CONV_ROWLOAD(p0 + 16 + i);
            }
            float f0[46], f1[46];
#pragma unroll
            for (int i = 0; i < 46; ++i) { f0[i] = bflo(in[i]); f1[i] = bfhi(in[i]); }
            float a0[16], a1[16];
#pragma unroll
            for (int o = 0; o < 16; ++o) { float x0 = bdw.x, x1 = bdw.y;
#pragma unroll
                for (int k = 0; k < 31; ++k) { x0 += w0[k] * f0[o + k]; x1 += w1[k] * f1[o + k]; }
                a0[o] = x0; a1[o] = x1; }
            float v16[16], v8[8], v4[4], v2[2], v1;
#pragma unroll
            for (int i = 0; i < 16; ++i) { const float sv = a0[i] + a1[i], qv = a0[i] * a0[i] + a1[i] * a1[i]; v16[i] = (b5 ? qv : sv) + __shfl_xor(b5 ? sv : qv, 32); }
#pragma unroll
            for (int i = 0; i < 8; ++i) v8[i] = (b4 ? v16[8 + i] : v16[i]) + __shfl_xor(b4 ? v16[i] : v16[8 + i], 16);
#pragma unroll
            for (int i = 0; i < 4; ++i) v4[i] = (b3 ? v8[4 + i] : v8[i]) + __shfl_xor(b3 ? v8[i] : v8[4 + i], 8);
#pragma unroll
            for (int i = 0; i < 2; ++i) v2[i] = (b2 ? v4[2 + i] : v4[i]) + __shfl_xor(b2 ? v4[i] : v4[2 + i], 4);
            v1 = (b1 ? v2[1] : v2[0]) + __shfl_xor(b1 ? v2[0] : v2[1], 2);
            v1 += __shfl_xor(v1, 1);
            if ((F.lane & 1) == 0) red[F.wave * 32 + (F.lane >> 1)] = v1;
            __syncthreads();
            if (tid < 16) { float ts = 0.f, tq = 0.f;
#pragma unroll
                for (int w = 0; w < 8; ++w) { ts += red[w * 32 + tid]; tq += red[w * 32 + 16 + tid]; }
                const float mean = ts * (1.0f / D), var = fmaxf(tq * (1.0f / D) - mean * mean, 0.f), rstd = __builtin_amdgcn_rsqf(var + LN_EPS);
                fin[2 * tid] = mean; fin[2 * tid + 1] = rstd; }
            __syncthreads();
#pragma unroll
            for (int o = 0; o < 16; ++o) {
                const float mean = fin[2 * o], rstd = fin[2 * o + 1];
                float y0 = (a0[o] - mean) * rstd * lg.x + lb.x, y1 = (a1[o] - mean) * rstd * lg.y + lb.y;
                y0 = y0 * sigmoidf_(y0); y1 = y1 * sigmoidf_(y1);
                const int pp = p0 + o, row = pp < NMETA ? NREAL + pp : b * SEQ + pp - NMETA;
                *(unsigned*)(C + (size_t)row * D + ch) = pk2(y0, y1);
            }
#pragma unroll
            for (int i = 0; i < 30; ++i) in[i] = in[i + 16];
        }
#undef CONV_ROWLOAD
    }
}

template <int LAYER> __device__ __forceinline__ void ln_route_phase(Frame& F, int nrows) {
    const bf16* Mx = (const bf16*)(F.ws + WS_R1); bf16* A = (bf16*)(F.ws + WS_A);
    unsigned* route_e = (unsigned*)(F.ws + WS_ROUTE_E); f32x2* route_w = (f32x2*)(F.ws + WS_ROUTE_W);
    LAS float* WL = (LAS float*)(F.lds + RING_OFF);
    LAS int* wcnt = (LAS int*)(F.lds + RING_OFF + 20 * 1024 * 4);
    const float* wg = F.in[21] + (size_t)LAYER * D * 4; const float* we = F.in[23] + (size_t)LAYER * D * 16;
    for (int k = F.tid; k < D; k += 512) { const f32x4 v = *(const f32x4*)(wg + (size_t)k * 4); WL[0 * D + k] = v.x; WL[1 * D + k] = v.y; WL[2 * D + k] = v.z; WL[3 * D + k] = v.w; }
    for (int i = F.tid; i < D * 4; i += 512) { const int k = i & (D - 1), q = i >> 10; const f32x4 v = *(const f32x4*)(we + (size_t)k * 16 + 4 * q);
        WL[(4 + 4 * q + 0) * D + k] = v.x; WL[(4 + 4 * q + 1) * D + k] = v.y; WL[(4 + 4 * q + 2) * D + k] = v.z; WL[(4 + 4 * q + 3) * D + k] = v.w; }
    __syncthreads();
    const float* gp = F.in[19] + (size_t)(LAYER * 2 + 0) * D; const float* bp = F.in[20] + (size_t)(LAYER * 2 + 0) * D;
    f32x4 gam[4], bet[4];
#pragma unroll
    for (int j = 0; j < 4; ++j) { gam[j] = *(const f32x4*)(gp + F.lane * 4 + 256 * j); bet[j] = *(const f32x4*)(bp + F.lane * 4 + 256 * j); }
    float bgr[4], bex[16];
#pragma unroll
    for (int o = 0; o < 4; ++o) bgr[o] = F.in[22][LAYER * 4 + o];
#pragma unroll
    for (int o = 0; o < 16; ++o) bex[o] = F.in[24][LAYER * 16 + o];
    const int gw = blockIdx.x * NWAVES + F.wave, NGW = F.G * NWAVES;
    int cnt = 0;
    LAS float* ps = (LAS float*)(F.lds + RING_OFF + 82432) + F.wave * (4 * 68);
#define LNR_A(r_, V) do { \
        const GAS v2u* mr_ = (const GAS v2u*)(Mx + (size_t)(r_) * D) + F.lane; \
        const GAS f32x4* hin_ = (const GAS f32x4*)h0row(F, LAYER == 0 ? (r_) : 0) + F.lane; \
        const GAS v2u* hb_ = (const GAS v2u*)(A + (size_t)(r_) * D) + F.lane;     \
        float s_ = 0.f; \
        _Pragma("unroll") for (int j = 0; j < 4; ++j) { const v2u a = mr_[64 * j]; f32x4 h; \
            if (LAYER == 0) h = hin_[64 * j]; else { const v2u hb = hb_[64 * j]; h = (f32x4){bflo(hb.x), bfhi(hb.x), bflo(hb.y), bfhi(hb.y)}; } \
            V[j] = ALPHA * h + (f32x4){bflo(a.x), bfhi(a.x), bflo(a.y), bfhi(a.y)}; s_ += (V[j].x + V[j].y) + (V[j].z + V[j].w); } \
        const float mean_ = wave_sum(s_) * (1.f / D); float s2_ = 0.f; \
        _Pragma("unroll") for (int j = 0; j < 4; ++j) { V[j] = V[j] - mean_; s2_ += (V[j].x * V[j].x + V[j].y * V[j].y) + (V[j].z * V[j].z + V[j].w * V[j].w); } \
        const float rstd_ = __builtin_amdgcn_rsqf(wave_sum(s2_) * (1.f / D) + LN_EPS); \
        GAS unsigned long long* o8_ = (GAS unsigned long long*)(A + (size_t)(r_) * D) + F.lane; \
        _Pragma("unroll") for (int j = 0; j < 4; ++j) { V[j] = V[j] * rstd_ * gam[j] + bet[j]; o8_[64 * j] = (unsigned long long)pk2(V[j].x, V[j].y) | ((unsigned long long)pk2(V[j].z, V[j].w) << 32); } \
    } while (0)
#define ROUTE_DOT4(OUT, V, wrow0) do { \
        _Pragma("unroll") for (int o = 0; o < 4; ++o) { \
            f32x2 p2_ = {0.f, 0.f}; \
            _Pragma("unroll") for (int j = 0; j < 4; ++j) { const f32x4 w = *(const LAS f32x4*)(WL + ((wrow0) + o) * D + F.lane * 4 + 256 * j); \
                p2_ = __builtin_elementwise_fma((f32x2){V[j].x, V[j].y}, (f32x2){w.x, w.y}, p2_); p2_ = __builtin_elementwise_fma((f32x2){V[j].z, V[j].w}, (f32x2){w.z, w.w}, p2_); } \
            OUT[o] = wave_sum(p2_.x + p2_.y); } } while (0)
#define LNR_B(r_, V) do { \
        float lgq[4], el[4]; \
        ROUTE_DOT4(lgq, V, 0); \
        float g0 = lgq[0] + bgr[0]; int gi = 0; \
        _Pragma("unroll") for (int o = 1; o < 4; ++o) { const float x = lgq[o] + bgr[o]; if (x > g0) { g0 = x; gi = o; } } \
        float gs = 0.f; \
        _Pragma("unroll") for (int o = 0; o < 4; ++o) gs += __expf(lgq[o] + bgr[o] - g0); \
        const float gwt = fast_rcp(gs);                              \
        const int giu = __builtin_amdgcn_readfirstlane(gi); \
        ROUTE_DOT4(el, V, 4 + 4 * giu); \
        _Pragma("unroll") for (int j = 0; j < 4; ++j) { float bb = bex[j]; \
            _Pragma("unroll") for (int g = 1; g < 4; ++g) bb = (gi == g) ? bex[4 * g + j] : bb; \
            el[j] += bb; } \
        float m1 = el[0]; int i1 = 0; \
        _Pragma("unroll") for (int j = 1; j < 4; ++j) if (el[j] > m1) { m1 = el[j]; i1 = j; } \
        float m2 = -INFINITY; int i2 = 0; \
        _Pragma("unroll") for (int j = 0; j < 4; ++j) if (j != i1 && el[j] > m2) { m2 = el[j]; i2 = j; } \
        const float p2 = __expf(m2 - m1);                          \
        const float w1 = gwt * fast_rcp(1.0f + p2), w2 = w1 * p2;     \
        const int e0 = __builtin_amdgcn_readfirstlane(gi * 4 + i1), e1 = __builtin_amdgcn_readfirstlane(gi * 4 + i2); \
        const int l0 = __builtin_amdgcn_readlane(cnt, e0); cnt += (F.lane == e0) ? 1 : 0; \
        const int l1 = __builtin_amdgcn_readlane(cnt, e1); cnt += (F.lane == e1) ? 1 : 0; \
        if (F.lane == 0) { route_e[(r_)] = (unsigned)e0 | ((unsigned)e1 << 4) | ((unsigned)l0 << 8) | ((unsigned)l1 << 16); route_w[(r_)] = (f32x2){w1, w2}; } \
    } while (0)
    if (gw < nrows) {
        f32x4 vp[4]; int rp = gw;
        LNR_A(gw, vp);
        for (int r = gw + NGW; r < nrows; r += NGW) {
            f32x4 vn[4];
            LNR_A(r, vn);
            LNR_B(rp, vp);
#pragma unroll
            for (int j = 0; j < 4; ++j) vp[j] = vn[j];
            rp = r;
        }
        LNR_B(rp, vp);
    }
#undef LNR_A
#undef LNR_B
#undef ROUTE_DOT4
    if (F.lane < 16) wcnt[F.wave * 16 + F.lane] = cnt;
    __syncthreads();
    if (F.tid < 16) {
        int* WB = (int*)(F.ws + WS_WB) + (size_t)blockIdx.x * 128; int* BC = (int*)(F.ws + WS_BCNT) + (size_t)blockIdx.x * 16;
        int run = 0;
#pragma unroll
        for (int w = 0; w < 8; ++w) { WB[w * 16 + F.tid] = run; run += wcnt[w * 16 + F.tid]; }
        BC[F.tid] = run;
    }
    __syncthreads();
}

__device__ __forceinline__ void dispatch_phase(Frame& F, int nrows) {
    int* rowidx = (int*)(F.ctl + CW_ROWIDX);
    const unsigned* route_e = (const unsigned*)(F.ws + WS_ROUTE_E); v2u* route_p = (v2u*)(F.ws + WS_ROUTE_P);
    const int* BC = (const int*)(F.ws + WS_BCNT); const int* WB = (const int*)(F.ws + WS_WB) + (size_t)blockIdx.x * 128;
    int* TS = (int*)(F.ws + WS_TSTART);
    LAS int* bc = (LAS int*)(F.lds + RING_OFF);
    LAS int* tot = (LAS int*)(F.lds + RING_OFF + 16384); LAS int* bpre = tot + 16; LAS int* base = tot + 32;
    for (int idx = F.tid; idx < F.G * 16; idx += 512) bc[idx] = BC[idx];
    __syncthreads();
    if (F.tid < 16) { int s = 0, pre = 0; for (int b = 0; b < F.G; ++b) { if (b == (int)blockIdx.x) pre = s; s += bc[b * 16 + F.tid]; } tot[F.tid] = s; bpre[F.tid] = pre; }
    __syncthreads();
    if (F.tid == 0) { int t = 0; for (int e = 0; e < 16; ++e) { if (blockIdx.x == 0) TS[e] = t; base[e] = t * 256 + bpre[e]; t += (tot[e] + 255) >> 8; } if (blockIdx.x == 0) TS[16] = t; }
    __syncthreads();
    const int mybase = (F.lane < 16) ? base[F.lane] + WB[F.wave * 16 + F.lane] : 0;
    const int gw = blockIdx.x * NWAVES + F.wave, NGW = F.G * NWAVES;
    for (int r = gw; r < nrows; r += NGW) {
        const unsigned re = __builtin_amdgcn_readfirstlane(route_e[r]);
        const int e0 = re & 15, e1 = (re >> 4) & 15, l0 = (re >> 8) & 255, l1 = (re >> 16) & 255;
        const int pos0 = __builtin_amdgcn_readlane(mybase, e0) + l0, pos1 = __builtin_amdgcn_readlane(mybase, e1) + l1;
        if (F.lane == 0) { route_p[r] = (v2u){(unsigned)pos0, (unsigned)pos1}; rowidx[pos0] = r; rowidx[pos1] = r; }
    }
    __syncthreads();
}

template <int LAYER, bool FINAL> __device__ __forceinline__ void ln_combine_phase(Frame& F, int nrows) {
    const bf16* Ys = (const bf16*)(F.ws + WS_R3); bf16* A = (bf16*)(F.ws + WS_A);
    const f32x2* route_w = (const f32x2*)(F.ws + WS_ROUTE_W); const v2u* route_p = (const v2u*)(F.ws + WS_ROUTE_P);
    const float* gp = F.in[19] + (size_t)(LAYER * 2 + 1) * D; const float* bp = F.in[20] + (size_t)(LAYER * 2 + 1) * D;
    f32x4 gam[4], bet[4];
#pragma unroll
    for (int j = 0; j < 4; ++j) { gam[j] = *(const f32x4*)(gp + F.lane * 4 + 256 * j); bet[j] = *(const f32x4*)(bp + F.lane * 4 + 256 * j); }
    const int gw = blockIdx.x * NWAVES + F.wave, NGW = F.G * NWAVES;
    for (int r = gw; r < nrows; r += NGW) {
        const f32x2 cw = route_w[r]; const v2u ps = route_p[r];
        const GAS v2u* hb = (const GAS v2u*)(A + (size_t)r * D) + F.lane;
        GAS f32x4* hr = (GAS f32x4*)(F.out + (size_t)(FINAL ? r : 0) * D) + F.lane;
        const GAS v2u* y0 = (const GAS v2u*)(Ys + (size_t)ps.x * D) + F.lane; const GAS v2u* y1 = (const GAS v2u*)(Ys + (size_t)ps.y * D) + F.lane;
        f32x4 v[4]; float s = 0.f;
#pragma unroll
        for (int j = 0; j < 4; ++j) {
            const v2u hq = hb[64 * j]; const f32x4 h = {bflo(hq.x), bfhi(hq.x), bflo(hq.y), bfhi(hq.y)}; const v2u a = y0[64 * j], b = y1[64 * j];
            const f32x4 fa = {bflo(a.x), bfhi(a.x), bflo(a.y), bfhi(a.y)}, fb = {bflo(b.x), bfhi(b.x), bflo(b.y), bfhi(b.y)};
            v[j] = ALPHA * h + (cw.x * fa + cw.y * fb);
            s += (v[j].x + v[j].y) + (v[j].z + v[j].w); }
        const float mean = wave_sum(s) * (1.f / D); float s2 = 0.f;
#pragma unroll
        for (int j = 0; j < 4; ++j) { v[j] = v[j] - mean; s2 += (v[j].x * v[j].x + v[j].y * v[j].y) + (v[j].z * v[j].z + v[j].w * v[j].w); }
        const float rstd = __builtin_amdgcn_rsqf(wave_sum(s2) * (1.f / D) + LN_EPS);
        GAS unsigned long long* o8 = (GAS unsigned long long*)(A + (size_t)r * D) + F.lane;
#pragma unroll
        for (int j = 0; j < 4; ++j) { v[j] = v[j] * rstd * gam[j] + bet[j]; if (FINAL) hr[64 * j] = v[j];
            if (!FINAL) o8[64 * j] = (unsigned long long)pk2(v[j].x, v[j].y) | ((unsigned long long)pk2(v[j].z, v[j].w) << 32); }
    }
}

namespace att {
constexpr int KOFF = 0, VOFF = 49152, XOFF = 98304, SLOT = 16384;
typedef __bf16 bf16x2_t __attribute__((ext_vector_type(2)));
__device__ __forceinline__ unsigned cvtpk_s(float lo, float hi) { f32x2 v = {lo, hi}; bf16x2_t b = __builtin_convertvector(v, bf16x2_t); return __builtin_bit_cast(unsigned, b); }
__device__ __forceinline__ bf16x8 packp(const f32x16& p, int s) {
    v4u w; w.x = cvtpk_s(p[8 * s + 0], p[8 * s + 1]); w.y = cvtpk_s(p[8 * s + 2], p[8 * s + 3]); w.z = cvtpk_s(p[8 * s + 4], p[8 * s + 5]); w.w = cvtpk_s(p[8 * s + 6], p[8 * s + 7]);
    return __builtin_bit_cast(bf16x8, w);
}
__device__ __forceinline__ void glds16(const void* gsrc, unsigned lds_dst) { unsigned keep;
    asm volatile("s_mov_b32 %0, m0\n\ts_mov_b32 m0, %2\n\ts_nop 0\n\tglobal_load_lds_dwordx4 %1, off\n\ts_mov_b32 m0, %0" : "=&s"(keep) : "v"(gsrc), "s"(lds_dst) : "memory"); }
template <int IMM> __device__ __forceinline__ void glds16s(const void* sbase, unsigned voff, unsigned lds_dst) { unsigned keep;
    asm volatile("s_mov_b32 %0, m0\n\ts_mov_b32 m0, %3\n\ts_nop 0\n\tglobal_load_lds_dwordx4 %1, %2 offset:%4\n\ts_mov_b32 m0, %0" : "=&s"(keep) : "v"(voff), "s"(sbase), "s"(lds_dst), "n"(IMM) : "memory"); }
#define ATT_BAR_V(N) asm volatile("s_waitcnt vmcnt(" #N ") lgkmcnt(0)\n\ts_barrier" ::: "memory")
#define ATT_BAR() asm volatile("s_waitcnt lgkmcnt(0)\n\ts_barrier" ::: "memory")
typedef short v4i16_t __attribute__((ext_vector_type(4)));
__device__ __forceinline__ s16x4 vtr(LAS const unsigned char* p) { return __builtin_bit_cast(s16x4, __builtin_amdgcn_ds_read_tr16_b64_v4i16((LAS v4i16_t*)p)); }

__device__ __forceinline__ void qk_tile(f32x16& s0, f32x16& s1, LAS const unsigned char* kb, int hi, int kx, const bf16x8 (&qf)[4], const f32x16& negv) {
#pragma unroll
    for (int d0 = 0; d0 < 4; ++d0) {
        const int co = ((2 * d0 + hi) ^ kx) << 4;
        const bf16x8 kf0 = *(LAS const bf16x8*)(kb + co), kf1 = *(LAS const bf16x8*)(kb + 4096 + co);
        s0 = __builtin_amdgcn_mfma_f32_32x32x16_bf16(kf0, qf[d0], d0 == 0 ? negv : s0, 0, 0, 0);
        s1 = __builtin_amdgcn_mfma_f32_32x32x16_bf16(kf1, qf[d0], d0 == 0 ? negv : s1, 0, 0, 0);
    }
}
template <bool FIRST> __device__ __forceinline__ float softmax_pack(f32x16& s0, f32x16& s1, bf16x8 (&P)[4]) {
#pragma unroll
    for (int r = 0; r < 16; ++r) { s0[r] = FIRST ? 0.f : fast_exp2(s0[r]); s1[r] = (FIRST && r < 8) ? 0.f : fast_exp2(s1[r]); }
    float sa = 0.f, sb = 0.f;
#pragma unroll
    for (int r = 0; r < 16; ++r) { sa += s0[r]; asm volatile("" : "+v"(sa)); sb += s1[r]; asm volatile("" : "+v"(sb)); }
    P[0] = packp(s0, 0); P[1] = packp(s0, 1); P[2] = packp(s1, 0); P[3] = packp(s1, 1);
    return sa + sb;
}
__device__ __forceinline__ void pv_tile(f32x16 (&Oa)[4], LAS const unsigned char* va0, LAS const unsigned char* va1, const bf16x8 (&P)[4]) {
#pragma unroll
    for (int dblk = 0; dblk < 4; ++dblk)
#pragma unroll
        for (int hs = 0; hs < 4; ++hs) {
            const s16x4 a0 = vtr(va0 + 4096 * hs + 512 * dblk);
            const s16x4 a1 = vtr(va1 + 4096 * hs + 2048 + 512 * dblk);
            const bf16x8 vf = {a0[0], a0[1], a0[2], a0[3], a1[0], a1[1], a1[2], a1[3]};
            Oa[dblk] = __builtin_amdgcn_mfma_f32_32x32x16_bf16(vf, P[hs], Oa[dblk], 0, 0, 0);
        }
}

template <bool DEFER = false> __device__ __forceinline__ void mseg(f32x16& s0, f32x16& s1, f32x16 (&Oa)[4], LAS const unsigned char* kb, int hi, int kx, const bf16x8 (&qf)[4], const f32x16& negv,
                                     LAS const unsigned char* va0, LAS const unsigned char* va1, const bf16x8 (&P)[4], s16x4 (*t0)[4] = nullptr, s16x4 (*t1)[4] = nullptr) {
    bf16x8 kf0[4], kf1[4];
#pragma unroll
    for (int d0 = 0; d0 < 4; ++d0) { const int co = ((2 * d0 + hi) ^ kx) << 4; kf0[d0] = *(LAS const bf16x8*)(kb + co); kf1[d0] = *(LAS const bf16x8*)(kb + 4096 + co); }
    s16x4 ga0[4], ga1[4], gb0[4], gb1[4];
#define VGRP(A0, A1, dblk) do { _Pragma("unroll") for (int hs = 0; hs < 4; ++hs) { A0[hs] = vtr(va0 + 4096 * hs + 512 * (dblk)); A1[hs] = vtr(va1 + 4096 * hs + 2048 + 512 * (dblk)); } } while (0)
#define PVGRP(A0, A1, dblk) do { _Pragma("unroll") for (int hs = 0; hs < 4; ++hs) { const bf16x8 vf = {A0[hs][0], A0[hs][1], A0[hs][2], A0[hs][3], A1[hs][0], A1[hs][1], A1[hs][2], A1[hs][3]}; \
        Oa[dblk] = __builtin_amdgcn_mfma_f32_32x32x16_bf16(vf, P[hs], Oa[dblk], 0, 0, 0); } } while (0)
    VGRP(ga0, ga1, 0);
    __builtin_amdgcn_sched_barrier(0);
#pragma unroll
    for (int d0 = 0; d0 < 4; ++d0) {
        s0 = __builtin_amdgcn_mfma_f32_32x32x16_bf16(kf0[d0], qf[d0], d0 == 0 ? negv : s0, 0, 0, 0);
        s1 = __builtin_amdgcn_mfma_f32_32x32x16_bf16(kf1[d0], qf[d0], d0 == 0 ? negv : s1, 0, 0, 0);
    }
    __builtin_amdgcn_sched_barrier(0);
    VGRP(gb0, gb1, 1); __builtin_amdgcn_sched_barrier(0); PVGRP(ga0, ga1, 0); __builtin_amdgcn_sched_barrier(0);
    VGRP(ga0, ga1, 2); __builtin_amdgcn_sched_barrier(0); PVGRP(gb0, gb1, 1); __builtin_amdgcn_sched_barrier(0);
    VGRP(gb0, gb1, 3); __builtin_amdgcn_sched_barrier(0); PVGRP(ga0, ga1, 2); __builtin_amdgcn_sched_barrier(0);
    if constexpr (DEFER) {
#pragma unroll
        for (int hs = 0; hs < 4; ++hs) { (*t0)[hs] = gb0[hs]; (*t1)[hs] = gb1[hs]; }
    } else PVGRP(gb0, gb1, 3);
#undef VGRP
#undef PVGRP
}

__device__ __forceinline__ void pv_last(f32x16& O3, const s16x4 (&t0)[4], const s16x4 (&t1)[4], const bf16x8 (&P)[4]) {
#pragma unroll
    for (int hs = 0; hs < 4; ++hs) { const bf16x8 vf = {t0[hs][0], t0[hs][1], t0[hs][2], t0[hs][3], t1[hs][0], t1[hs][1], t1[hs][2], t1[hs][3]};
        O3 = __builtin_amdgcn_mfma_f32_32x32x16_bf16(vf, P[hs], O3, 0, 0, 0); }
}
template <int VAR> __device__ __forceinline__ void attn_unit(Frame& F, int b, int h, int t, float lam) {
    const bf16* Q = (const bf16*)(F.ws + WS_R3); const bf16* Kb = (const bf16*)(F.ws + WS_K); const bf16* Vb = (const bf16*)(F.ws + WS_R1);
    bf16* O = (bf16*)(F.ws + (VAR ? WS_A : WS_R2));
    const unsigned* kmax = (const unsigned*)(F.ctl + CW_KMAX);
    LAS unsigned char* lds = F.lds + RING_OFF;
    int lane = F.lane; asm volatile("" : "+v"(lane));
    const int w = F.wave, r32 = lane & 31, hi = lane >> 5;
    const int g = w & 3, c = w >> 2;
    const int qrow = b * SEQ + 128 * t + 32 * g + r32;
    const int NT = 2 * t + 3, jmax = 2 * t + 1 + (g >> 1);
    unsigned koff, voff0, voff1;
    {
        const int row = 8 * w + (lane >> 3), sc = (lane & 7) ^ ((row >> 1) & 7);
        koff = (unsigned)(row * D + sc * 8) * 2u;
        const int rr = (lane >> 2) & 7, x = lane & 3, sub = lane >> 5;
        { const int q = w, rg = q >> 1, cp = q & 1, rowv = 8 * rg + rr, ch = 4 * (2 * cp + sub) + (x ^ ((rowv >> 2) & 3)); voff0 = (unsigned)(rowv * D + ch * 8) * 2u; }
        { const int q = w + 8, rg = q >> 1, cp = q & 1, rowv = 8 * rg + rr, ch = 4 * (2 * cp + sub) + (x ^ ((rowv >> 2) & 3)); voff1 = (unsigned)(rowv * D + ch * 8) * 2u; }
    }
    const char* kbu = (const char*)(Kb + ((size_t)b * LP) * D + h * 128);
    const char* vbu = (const char*)(Vb + ((size_t)b * LP) * D + h * 128);
    constexpr size_t TILEB = (size_t)64 * D * 2;
    const unsigned ldsb = (unsigned)(size_t)lds;
#define DMA_K(j, slot) do { glds16s<0>(kbu + (size_t)(j) * TILEB, koff, (unsigned)__builtin_amdgcn_readfirstlane(ldsb + KOFF + (slot) + w * 1024)); \
                            glds16s<0>(kbu + (size_t)(j) * TILEB, koff + 128u, (unsigned)__builtin_amdgcn_readfirstlane(ldsb + KOFF + (slot) + 8192 + w * 1024)); } while (0)
#define DMA_V(j, slot) do { glds16s<0>(vbu + (size_t)(j) * TILEB, voff0, (unsigned)__builtin_amdgcn_readfirstlane(ldsb + VOFF + (slot) + w * 1024)); \
                            glds16s<0>(vbu + (size_t)(j) * TILEB, voff1, (unsigned)__builtin_amdgcn_readfirstlane(ldsb + VOFF + (slot) + 8192 + w * 1024)); } while (0)
#define DMA_K2(j, slot) do { DMA_K(j, slot); glds16s<0>(kbu + (size_t)(j) * TILEB, koff + 65536u, (unsigned)__builtin_amdgcn_readfirstlane(ldsb + KOFF + (slot) + 4096 + w * 1024)); \
                             glds16s<0>(kbu + (size_t)(j) * TILEB, koff + 65536u + 128u, (unsigned)__builtin_amdgcn_readfirstlane(ldsb + KOFF + (slot) + 8192 + 4096 + w * 1024)); } while (0)
    DMA_K(0, 0); DMA_V(0, 0); DMA_K(1, SLOT); DMA_V(1, SLOT); DMA_K(2, 2 * SLOT);
    bf16x8 qf[4]; float negm;
    {
        float n2 = 0.f;
#pragma unroll
        for (int d0 = 0; d0 < 4; ++d0) {
            const v4u q = *(const v4u*)(Q + (size_t)qrow * D + h * 128 + c * 64 + d0 * 16 + hi * 8);
            qf[d0] = __builtin_bit_cast(bf16x8, q);
            const float x0 = bflo(q.x), x1 = bfhi(q.x), x2 = bflo(q.y), x3 = bfhi(q.y), x4 = bflo(q.z), x5 = bfhi(q.z), x6 = bflo(q.w), x7 = bfhi(q.w);
            n2 += (x0 * x0 + x1 * x1) + (x2 * x2 + x3 * x3) + (x4 * x4 + x5 * x5) + (x6 * x6 + x7 * x7); }
        n2 += __shfl_xor(n2, 32);
        const float ka = __builtin_bit_cast(float, kmax[(b * 16 + h * 2 + c) * 2 + 0]), kb2 = __builtin_bit_cast(float, kmax[(b * 16 + h * 2 + c) * 2 + 1]);
        negm = -(sqrtf(n2) * sqrtf(ka + kb2) * 1.01f + 0.01f);
    }
    f32x16 Oa[4];
#pragma unroll
    for (int i = 0; i < 4; ++i) Oa[i] = (f32x16){};
    float lsum = 0.f;
    f32x16 negv;
#pragma unroll
    for (int r = 0; r < 16; ++r) negv[r] = negm;
    asm volatile("" : "+v"(negv));
    const int kx = (r32 >> 1) & 7;
    const int pq = (lane & 15) >> 2, pp = lane & 3, blk = (lane >> 4) & 1;
    const int vb0 = 64 * (4 * hi + pq) + 16 * ((2 * blk + (pp >> 1)) ^ (hi + 0)) + 8 * (pp & 1);
    const int vb1 = 64 * (4 * hi + pq) + 16 * ((2 * blk + (pp >> 1)) ^ (hi + 2)) + 8 * (pp & 1);
    LAS const unsigned char* kbase = lds + KOFF + c * 8192 + r32 * 128;
    LAS const unsigned char* vbase0 = lds + VOFF + vb0;
    LAS const unsigned char* vbase1 = lds + VOFF + vb1;
    bf16x8 P[4];
    f32x16 s0, s1;
    ATT_BAR_V(0);
    qk_tile(s0, s1, kbase, hi, kx, qf, negv);
    lsum += softmax_pack<true>(s0, s1, P);
    ATT_BAR();
    int sk = 0, sk1 = SLOT, sv2 = 2 * SLOT;
    if (__builtin_amdgcn_readfirstlane(c) == 0) __builtin_amdgcn_s_setprio(1);
    int s = 0;
    if (!(VAR & 2)) {
        const int NTs = NT - 3;
        if (c == 0) {
            asm volatile(".p2align 6\n\t.fill " MK_STR(MK_ATT_PAD0) ", 4, 0xBF800000" ::: "memory");
#pragma unroll 1
            for (; s < NTs; ++s) {
                mseg<false>(s0, s1, Oa, kbase + sk1, hi, kx, qf, negv, vbase0 + sk, vbase1 + sk, P);
                DMA_K2(s + 3, sk); DMA_V(s + 2, sv2);
                lsum += softmax_pack<false>(s0, s1, P);
                ATT_BAR_V(6);
                { const int tmp = sk; sk = sk1; sk1 = sv2; sv2 = tmp; }
            }
        } else {
            asm volatile(".p2align 6\n\t.fill " MK_STR(MK_ATT_PAD1) ", 4, 0xBF800000" ::: "memory");
#pragma unroll 1
            for (; s < NTs; ++s) {
                s16x4 t0[4], t1[4];
                mseg<true>(s0, s1, Oa, kbase + sk1, hi, kx, qf, negv, vbase0 + sk, vbase1 + sk, P, &t0, &t1);
                ATT_BAR_V(0);
                DMA_V(s + 2, sv2);
                __builtin_amdgcn_sched_barrier(0); pv_last(Oa[3], t0, t1, P); __builtin_amdgcn_sched_barrier(0);
                lsum += softmax_pack<false>(s0, s1, P);
                { const int tmp = sk; sk = sk1; sk1 = sv2; sv2 = tmp; }
            }
        }
    }
#pragma unroll 1
    for (; s < NT; ++s) {
        if (s <= jmax) {

            mseg(s0, s1, Oa, kbase + sk1, hi, kx, qf, negv, vbase0 + sk, vbase1 + sk, P);

        }
        if (c == 1) ATT_BAR_V(0); else ATT_BAR();
        if (!(VAR & 2)) { if (s + 3 < NT) DMA_K(s + 3, sk); if (s + 2 < NT) DMA_V(s + 2, sv2); }
        if (s < jmax) lsum += softmax_pack<false>(s0, s1, P);
        if (c == 0) { if (s + 3 < NT) ATT_BAR_V(4); else ATT_BAR_V(0); } else ATT_BAR();
        { const int tmp = sk; sk = sk1; sk1 = sv2; sv2 = tmp; }
    }
    __builtin_amdgcn_s_setprio(0);
#undef DMA_K2
#undef DMA_K
#undef DMA_V
    lsum += __shfl_xor(lsum, 32);
    LAS float* X = (LAS float*)(lds + XOFF) + g * 2048 + lane;
    const float sc = (c == 1) ? lam / lsum : 1.0f / lsum;
    float ss = 0.f;
#pragma unroll
    for (int p = 0; p < 2; ++p) {
        if (c == 1) {
#pragma unroll
            for (int d2 = 0; d2 < 2; ++d2)
#pragma unroll
                for (int r = 0; r < 16; ++r) X[(d2 * 16 + r) * 64] = Oa[2 * p + d2][r] * sc;
        }
        __syncthreads();
        if (c == 0) {
#pragma unroll
            for (int d2 = 0; d2 < 2; ++d2)
#pragma unroll
                for (int r = 0; r < 16; ++r) { const float o = Oa[2 * p + d2][r] * sc - X[(d2 * 16 + r) * 64]; Oa[2 * p + d2][r] = o; ss += o * o; }
        }
        __syncthreads();
    }
    if (c == 0) {
        ss += __shfl_xor(ss, 32);
        const float rn = (1.0f / sqrtf(ss * (1.0f / 128.0f) + LN_EPS)) * (1.0f - LAM_INIT);
        const float* sg = F.in[17];
        bf16* orow = O + (size_t)qrow * D + h * 128;
#pragma unroll
        for (int dblk = 0; dblk < 4; ++dblk)
#pragma unroll
            for (int m = 0; m < 2; ++m) {
                v2u wq[2];
#pragma unroll
                for (int e = 0; e < 2; ++e) { const int rq = 2 * m + e, d0 = 32 * dblk + 8 * rq + 4 * hi;
                    const f32x4 gg = *(const f32x4*)(sg + d0);
                    wq[e].x = pk2(Oa[dblk][4 * rq + 0] * rn * gg.x, Oa[dblk][4 * rq + 1] * rn * gg.y); wq[e].y = pk2(Oa[dblk][4 * rq + 2] * rn * gg.z, Oa[dblk][4 * rq + 3] * rn * gg.w); }
                const auto sx = __builtin_amdgcn_permlane32_swap(wq[0].x, wq[1].x, false, false);
                const auto sy = __builtin_amdgcn_permlane32_swap(wq[0].y, wq[1].y, false, false);
                v4u w16; w16.x = sx[0]; w16.y = sy[0]; w16.z = sx[1]; w16.w = sy[1];
                *(v4u*)(orow + 32 * dblk + 16 * m + 8 * hi) = w16;
            }
    }
}
template <int VAR> __device__ __forceinline__ void attn_phase(Frame& F) {
    const float d1 = wave_sum(F.in[13][F.lane] * F.in[14][F.lane]), d2 = wave_sum(F.in[15][F.lane] * F.in[16][F.lane]);
    const float lam = __expf(d1) - __expf(d2) + LAM_INIT;
    for (int pi = F.vcu; pi < 1024; pi += F.G) {
        const int bh = pi >> 6, tp = pi & 63;
#pragma unroll 1
        for (int k = 0; k < 2; ++k) attn_unit<VAR>(F, bh >> 3, bh & 7, k ? 127 - tp : tp, lam);
    }
}
}

constexpr int N_PHASES = 17;
struct Args { const float* in[28]; float* out; unsigned char* ws; int ph_lo, ph_hi, li, pad; };
__global__ void __launch_bounds__(NWAVES * 64, 2) mk_fwd(Args args) {
    extern __shared__ __attribute__((aligned(16))) unsigned char lds[];
    Frame F;
    F.lds = (LAS unsigned char*)lds;
    F.MISC = (volatile LAS unsigned*)(F.lds + MISC_OFF);
    F.tid = threadIdx.x; F.lane = F.tid & 63; F.wave = __builtin_amdgcn_readfirstlane(F.tid >> 6);
    F.G = gridDim.x; { const int bx = blockIdx.x; F.vcu = (F.G % 8 == 0) ? (bx % 8) * (F.G / 8) + bx / 8 : bx; }
    F.ws = args.ws; F.ctl = (gu32*)(args.ws + WS_CTL); F.out = args.out;
#pragma unroll
    for (int i = 0; i < 28; ++i) F.in[i] = args.in[i];
    for (int u = F.tid; u < (LDS_BYTES - LDSCTL_OFF) / 4; u += NWAVES * 64) ((LAS unsigned*)(F.lds + LDSCTL_OFF))[u] = 0u;
    __syncthreads();
    const bool one_phase = (args.ph_hi - args.ph_lo) == 1;
    XcdBarrier bar; bar.bar = (unsigned*)(F.ctl + CW_BAR) + args.li * XCD_BAR_WORDS; bar.x = 0; bar.st = nullptr;
    if (!one_phase) bar = xcd_barrier_post((unsigned*)(F.ctl + CW_BAR) + args.li * XCD_BAR_WORDS, F.MISC + 8);
    const int lo = args.ph_lo, hi = args.ph_hi;
#ifndef PHMASK
#define PHMASK 0x1ffff
#endif
#define IN(k) ((((PHMASK) >> (k)) & 1) && lo <= (k) && (k) < hi)
#define SEAM(k) do { if (IN(k) && IN((k) + 1)) xcd_barrier(bar); } while (0)
    unsigned char* ws = args.ws;
    bf16* A = (bf16*)(ws + WS_A);
    const int* TS = (const int*)(ws + WS_TSTART);

    if (IN(0)) { p0_prologue(F); SEAM(0); }
    if (IN(1)) {
        DenseOrder S; S.init(A, ws + WS_WPW1, D, NREAL / 256, 8, F.G, (int)blockIdx.x);
        EpiGLU E{(bf16*)(ws + WS_R2), F.in[3]};
        pg8::gemm_phase<EpiGLU, DenseOrder, true, true>(F.lds + RING_OFF, D, S, E);
        mini_glu(F);
        SEAM(1);
    }
    if (IN(2)) { conv_phase(F); SEAM(2); }
    if (IN(3)) {
        DenseOrder S; S.init(ws + WS_R3, ws + WS_WPW2, D, NREAL / 256, 4, F.G, (int)blockIdx.x);
        EpiBf16 E{(bf16*)(ws + WS_R1), F.in[9]};
        pg8::gemm_phase<EpiBf16, DenseOrder, true, true>(F.lds + RING_OFF, D, S, E);
        mini_pw2(F);
        SEAM(3);
    }
    if (IN(4)) { ln_route_phase<0>(F, NTOK0); SEAM(4); }
    if (IN(5)) { dispatch_phase(F, NTOK0); SEAM(5); }
    if (IN(6)) {
        MoeOrder S; S.init(A, ws + WS_W13, D, 4, (size_t)D * D * 2, TS, F.G, (int)blockIdx.x); S.gather = true;
        LAS int* gtab = (LAS int*)(F.lds + GTAB_OFF);
        { const int* rowidx = (const int*)(F.ctl + CW_ROWIDX); pg8::Unit gu;
#pragma unroll
          for (int i = 0; i < 6; ++i) if (S.next(i, gu) && F.tid < 256) gtab[i * 256 + F.tid] = rowidx[gu.pm * 256 + F.tid];
          __syncthreads(); }
        EpiSwiGLU E{(bf16*)(ws + WS_R2)};
        pg8::gemm_phase<EpiSwiGLU, MoeOrder, true, true, true>(F.lds + RING_OFF, D, S, E, gtab);
        {
            const int nlate = S.d.nwg - 4 * F.G;
            if (nlate <= 0 || nlate >= F.G) moe_weights_convert(F, 1, blockIdx.x * NWAVES + F.wave, F.G * NWAVES);
            else if ((int)blockIdx.x >= nlate) moe_weights_convert(F, 1, ((int)blockIdx.x - nlate) * NWAVES + F.wave, (F.G - nlate) * NWAVES);
        }
        SEAM(6);
    }
    if (IN(7)) {
        MoeOrder S; S.init(ws + WS_R2, ws + WS_W2T, DE, 4, (size_t)D * DE * 2, TS, F.G, (int)blockIdx.x);
        EpiBf16 E{(bf16*)(ws + WS_R3), nullptr};
        pg8::gemm_phase<EpiBf16, MoeOrder, true, true>(F.lds + RING_OFF, DE, S, E);
        SEAM(7);
    }
    if (IN(8)) {
        ln_combine_phase<0, false>(F, NTOK0);
        SEAM(8);
    }
    if (IN(9)) {
        if (blockIdx.x == 0) {
            for (int i = F.tid; i < 2 * 2 * 48 * 128; i += 512) { const int which = i / (2 * 48 * 128), rem = i % (2 * 48 * 128), bb = rem / (48 * 128), o = rem % (48 * 128);
                v4u* p = (v4u*)((which ? ws + WS_R1 : ws + WS_K) + (size_t)bb * LP * D * 2) + o; *p = (v4u){0u, 0u, 0u, 0u}; }
        }
        DenseOrder S; S.init(A, ws + WS_WQKV, D, NREAL / 256, 12, F.G, (int)blockIdx.x);
        EpiQKV E{(bf16*)(ws + WS_R3), (bf16*)(ws + WS_K), (bf16*)(ws + WS_R1), (const f32x4*)(ws + WS_ROPE), (unsigned*)(F.ctl + CW_KMAX)};
        pg8::gemm_phase<EpiQKV, DenseOrder, true, true>(F.lds + RING_OFF, D, S, E);
        mini_kv(F);
        SEAM(9);
    }
#ifndef MK_ATT_PROBE
#define MK_ATT_PROBE 0
#endif
    asm volatile(".p2align 6\n\t.fill " MK_STR(MK_ATT_PAD) ", 4, 0xBF800000" ::: "memory");
    if (IN(10)) { att::attn_phase<0>(F); if (MK_ATT_PROBE) { __syncthreads(); att::attn_phase<MK_ATT_PROBE>(F); } SEAM(10); }
    if (IN(11)) {
        DenseOrder S; S.init(ws + WS_R2, ws + WS_WO, D, NREAL / 256, 4, F.G, (int)blockIdx.x);
        EpiBf16 E{(bf16*)(ws + WS_R1), nullptr};
        pg8::gemm_phase<EpiBf16, DenseOrder, true, true>(F.lds + RING_OFF, D, S, E);
        SEAM(11);
    }
    if (IN(12)) { ln_route_phase<1>(F, NREAL); SEAM(12); }
    if (IN(13)) { dispatch_phase(F, NREAL); SEAM(13); }
    if (IN(14)) {
        MoeOrder S; S.init(A, ws + WS_W13B, D, 4, (size_t)D * D * 2, TS, F.G, (int)blockIdx.x); S.gather = true;
        LAS int* gtab = (LAS int*)(F.lds + GTAB_OFF);
        { const int* rowidx = (const int*)(F.ctl + CW_ROWIDX); pg8::Unit gu;
#pragma unroll
          for (int i = 0; i < 6; ++i) if (S.next(i, gu) && F.tid < 256) gtab[i * 256 + F.tid] = rowidx[gu.pm * 256 + F.tid];
          __syncthreads(); }
        EpiSwiGLU E{(bf16*)(ws + WS_R2)};
        pg8::gemm_phase<EpiSwiGLU, MoeOrder, true, true, true>(F.lds + RING_OFF, D, S, E, gtab);
        SEAM(14);
    }
    if (IN(15)) {
        MoeOrder S; S.init(ws + WS_R2, ws + WS_W2TB, DE, 4, (size_t)D * DE * 2, TS, F.G, (int)blockIdx.x);
        EpiBf16 E{(bf16*)(ws + WS_R3), nullptr};
        pg8::gemm_phase<EpiBf16, MoeOrder, true, true>(F.lds + RING_OFF, DE, S, E);
        SEAM(15);
    }
    if (IN(16)) { ln_combine_phase<1, true>(F, NREAL); }
#ifdef MK_DUMP
    if (lo == 17) {
        const int gw = blockIdx.x * NWAVES + F.wave, NGW = F.G * NWAVES;
        const bf16* Qd = (const bf16*)(ws + WS_R3); const bf16* Kd = (const bf16*)(ws + WS_K); const bf16* Vd = (const bf16*)(ws + WS_R1); const bf16* Od = (const bf16*)(ws + WS_R2);
        for (int r = gw; r < NREAL; r += NGW) {
            const int b = r >> 14, sq = r & (SEQ - 1);
            for (int j = 0; j < 16; ++j) { const int c = F.lane + 64 * j;
                float v = 0.f;
                if (MK_DUMP == 1) v = bflo(Qd[(size_t)r * D + c]) + bflo(Kd[((size_t)b * LP + 64 + sq) * D + c]) + bflo(Vd[((size_t)b * LP + 64 + sq) * D + c]);
                if (MK_DUMP == 2) v = bflo(Od[(size_t)r * D + c]);
                if (MK_DUMP == 4) { v = 0.f;
                    if (r < 64) v = bflo(Kd[(size_t)r * D + c]); else if (r < 128) v = bflo(Vd[(size_t)(r - 64) * D + c]);
                    else if (r < 192) v = bflo(Kd[((size_t)LP + r - 128) * D + c]); else if (r < 256) v = bflo(Vd[((size_t)LP + r - 192) * D + c]);
                    else if (r == 256 && c < 64) v = __builtin_bit_cast(float, ((const unsigned*)(F.ctl + CW_KMAX))[c]);
                    if (!(fabsf(v) < 1e30f)) v = 100.0f; }
                if (MK_DUMP == 3) { v = bflo(Od[(size_t)r * D + c]); if (!(fabsf(v) < 1e30f)) v = 100.0f; }
                F.out[(size_t)r * D + c] = v; }
        }
    }
#endif
#undef IN
#undef SEAM
}

extern "C" void kernel_launch(void* const* d_in, const int* in_sizes, int n_in, void* d_out, int out_size, void* d_ws, size_t ws_size, hipStream_t stream) {
    static int grid = 0;
    if (grid == 0) {
        if (n_in != 28 || out_size != NREAL * D || ws_size < WS_END) { fprintf(stderr, "kernel_launch: unexpected shapes (n_in %d, out %d, ws %zu); nothing launched\n", n_in, out_size, ws_size); grid = -1; return; }
        int dev = 0, cus = 0, per_cu = 0;
        if (hipGetDevice(&dev) != hipSuccess || hipDeviceGetAttribute(&cus, hipDeviceAttributeMultiprocessorCount, dev) != hipSuccess) { grid = -1; return; }
        if (hipFuncSetAttribute((const void*)mk_fwd, hipFuncAttributeMaxDynamicSharedMemorySize, LDS_BYTES) != hipSuccess) { fprintf(stderr, "kernel_launch: hipFuncSetAttribute failed\n"); grid = -1; return; }
        if (hipOccupancyMaxActiveBlocksPerMultiprocessor(&per_cu, (const void*)mk_fwd, NWAVES * 64, LDS_BYTES) != hipSuccess || per_cu < 1) { fprintf(stderr, "kernel_launch: occupancy query says %d\n", per_cu); }
        (void)hipGetLastError();
        grid = cus > 256 ? 256 : cus;
    }
    if (grid < 0) return;
    if (hipMemsetAsync((char*)d_ws + WS_CTL, 0, CTL_ZERO_BYTES, stream) != hipSuccess) return;
    Args a{};
    for (int i = 0; i < 28; ++i) a.in[i] = (const float*)d_in[i];
    a.out = (float*)d_out; a.ws = (unsigned char*)d_ws;
#ifdef MK_PROBE_SCHED
    { static const int sched[] = MK_PROBE_SCHED;
      for (unsigned k = 0; k < sizeof(sched) / sizeof(sched[0]); ++k) { a.ph_lo = sched[k]; a.ph_hi = sched[k] + 1; a.li = 0; a.pad = 0; hipLaunchKernelGGL(mk_fwd, dim3(grid), dim3(NWAVES * 64), LDS_BYTES, stream, a); }
      return; }
#endif
    constexpr int NL = MK_N_LAUNCHES;
#ifndef MK_STOP
#define MK_STOP N_PHASES
#endif
    for (int li = 0; li < NL && li < MK_STOP; ++li) {
        a.ph_lo = (NL == 1) ? 0 : li; a.ph_hi = (NL == 1) ? N_PHASES : li + 1; a.li = (NL == 1) ? 0 : 0; a.pad = 0;
        hipLaunchKernelGGL(mk_fwd, dim3(grid), dim3(NWAVES * 64), LDS_BYTES, stream, a);
    }
#ifdef MK_DUMP
    a.ph_lo = 17; a.ph_hi = 18; a.li = 0; hipLaunchKernelGGL(mk_fwd, dim3(grid), dim3(NWAVES * 64), LDS_BYTES, stream, a);
#endif
}
```
